# Optimizing an MI355X kernel written in HIP

```python
import math
import jax, jax.numpy as jnp
from jax import lax
import numpy as np

D_MODEL = 1024
BATCH = 1
SEQ = 16384
DEPTH = 2
DEC_BATCH = 128
DEC_SEQ = 4
PAST_LEN = 16384
PAGE_SIZE = 128

N_MIXERS = 2
N_ATTN_LAYERS = (DEPTH + 1) // 2
N_GLA_LAYERS = DEPTH // 2
HEAD_DIM = 64
N_Q_HEADS = D_MODEL // HEAD_DIM
N_KV_HEADS = 4
GROUP = N_Q_HEADS // N_KV_HEADS
WINDOW = 128
ATTN_BLOCK = 128
GLA_HEADS = 4
GLA_DK = (D_MODEL // 2) // GLA_HEADS
GLA_DV = D_MODEL // GLA_HEADS
GLA_GATE_RANK = 16
GLA_TAU = 16.0
GLA_CHUNK = 64
D_FF = 4 * D_MODEL
ALPHA = (2.0 * DEPTH) ** 0.25
BETA = (8.0 * DEPTH) ** -0.25
LN_EPS = 1e-5

kernel_name = "hybrid_swa_sink_gla_deepnorm_adaln_step"

F32 = jnp.float32


def _layernorm(x, g, b):
    xf = x.astype(F32)
    mu = jnp.mean(xf, axis=-1, keepdims=True)
    var = jnp.mean(jnp.square(xf - mu), axis=-1, keepdims=True)
    return ((xf - mu) * lax.rsqrt(var + LN_EPS) * g.astype(F32) + b.astype(F32)).astype(x.dtype)


def _adaln(c, w_mod, b_mod):
    mod = jax.nn.silu(c) @ w_mod + b_mod
    shift, scale, gate = jnp.split(mod, 3, axis=-1)
    return shift[:, None, :], scale[:, None, :], gate[:, None, :]


def _alibi_slopes():
    h = jnp.arange(1, N_Q_HEADS + 1, dtype=F32)
    return jnp.exp2(-8.0 * h / N_Q_HEADS).reshape(N_KV_HEADS, GROUP)


def _attend(q, k, v, qpos, kpos, sinks):
    s = jnp.einsum('bntkgd,bnskd->bnkgts', q, k).astype(F32) * (HEAD_DIM ** -0.5)
    dist = qpos[:, :, None] - kpos[:, None, :]
    valid = (dist >= 0) & (dist <= WINDOW) & (kpos[:, None, :] >= 0)
    slopes = _alibi_slopes()
    s = s - slopes[:, :, None, None] * dist[None, :, None, None].astype(F32)
    s = jnp.where(valid[None, :, None, None], s, -jnp.inf)
    sink = jnp.broadcast_to(sinks.astype(F32).reshape(N_KV_HEADS, GROUP, 1, 1), s.shape[:-1] + (1,))
    p = jax.nn.softmax(jnp.concatenate([s, sink], axis=-1), axis=-1)[..., :-1]
    return jnp.einsum('bnkgts,bnskd->bntkgd', p.astype(v.dtype), v)


def _attn_mixer(h, w_in, w_out, sinks, cache_k, cache_v, pos0):
    B, L, _ = h.shape
    qkv = h @ w_in
    nq, nkv = N_Q_HEADS * HEAD_DIM, N_KV_HEADS * HEAD_DIM
    q, k, v = jnp.split(qkv, [nq, nq + nkv], axis=-1)
    q = q.reshape(B, L, N_KV_HEADS, GROUP, HEAD_DIM)
    k = k.reshape(B, L, N_KV_HEADS, HEAD_DIM)
    v = v.reshape(B, L, N_KV_HEADS, HEAD_DIM)
    if cache_k is None:
        nb = L // ATTN_BLOCK
        qb = q.reshape(B, nb, ATTN_BLOCK, N_KV_HEADS, GROUP, HEAD_DIM)
        kb = k.reshape(B, nb, ATTN_BLOCK, N_KV_HEADS, HEAD_DIM)
        vb = v.reshape(B, nb, ATTN_BLOCK, N_KV_HEADS, HEAD_DIM)
        padw = ((0, 0), (1, 0), (0, 0), (0, 0), (0, 0))
        kk = jnp.concatenate([jnp.pad(kb, padw)[:, :-1], kb], axis=2)
        vv = jnp.concatenate([jnp.pad(vb, padw)[:, :-1], vb], axis=2)
        qpos = pos0 + jnp.arange(L, dtype=jnp.int32).reshape(nb, ATTN_BLOCK)
        kpos = jnp.concatenate([qpos - ATTN_BLOCK, qpos], axis=1)
        o = _attend(qb, kk, vv, qpos, kpos, sinks)
        w = min(WINDOW, L)
        new_k, new_v = k[:, L - w:], v[:, L - w:]
    else:
        W = cache_k.shape[1]
        kk = jnp.concatenate([cache_k.astype(k.dtype), k], axis=1)
        vv = jnp.concatenate([cache_v.astype(v.dtype), v], axis=1)
        qpos = (pos0 + jnp.arange(L, dtype=jnp.int32))[None]
        kpos = (pos0 - W + jnp.arange(W + L, dtype=jnp.int32))[None]
        o = _attend(q[:, None], kk[:, None], vv[:, None], qpos, kpos, sinks)
        new_k, new_v = kk[:, L:], vv[:, L:]
    o = o.reshape(B, L, nq) @ w_out
    return o, new_k, new_v


def _gla_chunked(q, k, v, lg, S0):
    B, L, H, dk = q.shape
    C = min(GLA_CHUNK, L)
    pad = (-L) % C
    n = (L + pad) // C

    def blk(a):
        a = jnp.pad(a.astype(F32), ((0, 0), (0, pad), (0, 0), (0, 0)))
        return a.reshape(B, n, C, H, a.shape[-1])

    q, k, v, lg = blk(q), blk(k), blk(v), blk(lg)
    b = jnp.cumsum(lg, axis=2)
    qd = q * jnp.exp(b)
    kd = k * jnp.exp(-b)
    causal = jnp.tril(jnp.ones((C, C), dtype=bool))
    A = jnp.where(causal, jnp.einsum('bnthk,bnshk->bnhts', qd, kd), 0.0)
    o_intra = jnp.einsum('bnhts,bnshv->bnthv', A, v)
    bC = b[:, :, -1]
    kdec = k * jnp.exp(bC[:, :, None] - b)

    def step(S, inp):
        qd_c, kdec_c, v_c, bC_c = inp
        o_c = jnp.einsum('bthk,bhkv->bthv', qd_c, S)
        S = jnp.exp(bC_c)[..., None] * S + jnp.einsum('bthk,bthv->bhkv', kdec_c, v_c)
        return S, o_c

    S, o_inter = lax.scan(step, S0.astype(F32),
                          (jnp.moveaxis(qd, 1, 0), jnp.moveaxis(kdec, 1, 0),
                           jnp.moveaxis(v, 1, 0), jnp.moveaxis(bC, 1, 0)))
    o = o_intra + jnp.moveaxis(o_inter, 0, 1)
    return o.reshape(B, n * C, H, -1)[:, :L], S


def _gla_mixer(h, w_in, w_gate_up, b_gate, norm_g, w_out, S0):
    B, L, _ = h.shape
    nk, nv = GLA_HEADS * GLA_DK, GLA_HEADS * GLA_DV
    proj = h @ w_in
    q, k, v, r, gdown = jnp.split(proj, [nk, 2 * nk, 2 * nk + nv, 2 * nk + 2 * nv], axis=-1)
    lg = jax.nn.log_sigmoid((gdown @ w_gate_up + b_gate).astype(F32)) / GLA_TAU
    q = q.reshape(B, L, GLA_HEADS, GLA_DK) * (GLA_DK ** -0.5)
    k = k.reshape(B, L, GLA_HEADS, GLA_DK)
    v = v.reshape(B, L, GLA_HEADS, GLA_DV)
    lg = lg.reshape(B, L, GLA_HEADS, GLA_DK)
    if S0 is None:
        S0 = jnp.zeros((B, GLA_HEADS, GLA_DK, GLA_DV), F32)
    o, S = _gla_chunked(q, k, v, lg, S0)
    o = o * lax.rsqrt(jnp.mean(jnp.square(o), axis=-1, keepdims=True) + LN_EPS) * norm_g.astype(F32)
    o = o.reshape(B, L, nv) * jax.nn.silu(r.astype(F32))
    return o.astype(h.dtype) @ w_out, S


def _mlp(h, w1, w2):
    return jnp.square(jax.nn.relu(h @ w1)) @ w2


def _trunk(x, c, caches_k, caches_v, states, pos0, w_mod, b_mod, ln_g, ln_b,
           attn_w_in, attn_w_out, attn_sinks, gla_w_in, gla_w_gate_up, gla_b_gate,
           gla_norm_g, gla_w_out, mlp_w1, mlp_w2):
    new_k, new_v, new_s = [], [], []
    for i in range(DEPTH):
        j = i // N_MIXERS
        shift, scale, gate = _adaln(c, w_mod[i, 0], b_mod[i, 0])
        h = x * (1.0 + scale) + shift
        if i % N_MIXERS == 0:
            ck = None if caches_k is None else caches_k[j]
            cv = None if caches_v is None else caches_v[j]
            out, kn, vn = _attn_mixer(h, attn_w_in[j], attn_w_out[j], attn_sinks[j], ck, cv, pos0)
            new_k.append(kn)
            new_v.append(vn)
        else:
            s0 = None if states is None else states[j]
            out, sn = _gla_mixer(h, gla_w_in[j], gla_w_gate_up[j], gla_b_gate[j],
                                 gla_norm_g[j], gla_w_out[j], s0)
            new_s.append(sn)
        x = _layernorm(ALPHA * x + gate * out, ln_g[i, 0], ln_b[i, 0])
        shift, scale, gate = _adaln(c, w_mod[i, 1], b_mod[i, 1])
        out = _mlp(x * (1.0 + scale) + shift, mlp_w1[i], mlp_w2[i])
        x = _layernorm(ALPHA * x + gate * out, ln_g[i, 1], ln_b[i, 1])
    return x, jnp.stack(new_k), jnp.stack(new_v), jnp.stack(new_s)


def setup_inputs(seed: int = 0) -> dict:
    key = jax.random.key(seed)
    ks = jax.random.split(key, 24)
    nrm = jax.random.normal
    win = min(WINDOW, PAST_LEN)
    nq, nkv = N_Q_HEADS * HEAD_DIM, N_KV_HEADS * HEAD_DIM
    nk, nv = GLA_HEADS * GLA_DK, GLA_HEADS * GLA_DV
    attn_cols = nq + 2 * nkv
    gla_cols = 2 * nk + 2 * nv + GLA_GATE_RANK
    attn_col_scale = jnp.concatenate([jnp.ones((nq + nkv,), F32), jnp.full((nkv,), BETA, F32)])
    gla_col_scale = jnp.concatenate([jnp.ones((2 * nk,), F32), jnp.full((nv,), BETA, F32),
                                     jnp.ones((nv + GLA_GATE_RANK,), F32)])
    return {
        "x_prompt": nrm(ks[0], (BATCH, SEQ, D_MODEL), F32),
        "x_sample": nrm(ks[1], (DEC_BATCH, DEC_SEQ, D_MODEL), F32),
        "cache_k": nrm(ks[2], (N_ATTN_LAYERS, DEC_BATCH, win, N_KV_HEADS, HEAD_DIM), F32),
        "cache_v": nrm(ks[3], (N_ATTN_LAYERS, DEC_BATCH, win, N_KV_HEADS, HEAD_DIM), F32),
        "state_gla": nrm(ks[4], (N_GLA_LAYERS, DEC_BATCH, GLA_HEADS, GLA_DK, GLA_DV), F32),
        "c_prompt": nrm(ks[5], (BATCH, D_MODEL), F32),
        "c_sample": nrm(ks[6], (DEC_BATCH, D_MODEL), F32),
        "w_mod": nrm(ks[7], (DEPTH, 2, D_MODEL, 3 * D_MODEL), F32) * D_MODEL ** -0.5,
        "b_mod": nrm(ks[8], (DEPTH, 2, 3 * D_MODEL), F32) * 0.02,
        "ln_g": 1.0 + 0.02 * nrm(ks[9], (DEPTH, 2, D_MODEL), F32),
        "ln_b": 0.02 * nrm(ks[10], (DEPTH, 2, D_MODEL), F32),
        "attn_w_in": nrm(ks[11], (N_ATTN_LAYERS, D_MODEL, attn_cols), F32) * D_MODEL ** -0.5 * attn_col_scale,
        "attn_w_out": nrm(ks[12], (N_ATTN_LAYERS, nq, D_MODEL), F32) * nq ** -0.5 * BETA,
        "attn_sinks": nrm(ks[13], (N_ATTN_LAYERS, N_Q_HEADS), F32),
        "gla_w_in": nrm(ks[14], (N_GLA_LAYERS, D_MODEL, gla_cols), F32) * D_MODEL ** -0.5 * gla_col_scale,
        "gla_w_gate_up": nrm(ks[15], (N_GLA_LAYERS, GLA_GATE_RANK, nk), F32) * GLA_GATE_RANK ** -0.5,
        "gla_b_gate": 0.1 * nrm(ks[16], (N_GLA_LAYERS, nk), F32),
        "gla_norm_g": 1.0 + 0.02 * nrm(ks[17], (N_GLA_LAYERS, GLA_DV), F32),
        "gla_w_out": nrm(ks[18], (N_GLA_LAYERS, nv, D_MODEL), F32) * nv ** -0.5 * BETA,
        "mlp_w1": nrm(ks[19], (DEPTH, D_MODEL, D_FF), F32) * D_MODEL ** -0.5,
        "mlp_w2": nrm(ks[20], (DEPTH, D_FF, D_MODEL), F32) * D_FF ** -0.5 * BETA,
    }


def reference(x_prompt, x_sample, cache_k, cache_v, state_gla, c_prompt, c_sample,
              w_mod, b_mod, ln_g, ln_b, attn_w_in, attn_w_out, attn_sinks,
              gla_w_in, gla_w_gate_up, gla_b_gate, gla_norm_g, gla_w_out, mlp_w1, mlp_w2):
    y_prompt, k_p, v_p, s_p = _trunk(
        x_prompt, c_prompt, None, None, None, 0, w_mod, b_mod, ln_g, ln_b,
        attn_w_in, attn_w_out, attn_sinks, gla_w_in, gla_w_gate_up, gla_b_gate,
        gla_norm_g, gla_w_out, mlp_w1, mlp_w2)
    y_sample, k_s, v_s, s_s = _trunk(
        x_sample, c_sample, cache_k, cache_v, state_gla, PAST_LEN, w_mod, b_mod, ln_g, ln_b,
        attn_w_in, attn_w_out, attn_sinks, gla_w_in, gla_w_gate_up, gla_b_gate,
        gla_norm_g, gla_w_out, mlp_w1, mlp_w2)
    return (y_prompt, y_sample, k_p, v_p, s_p, k_s, v_s, s_s)
```

```cpp
#include <hip/hip_runtime.h>
#include <hip/hip_cooperative_groups.h>
#include <cstdio>
#include <cstdint>
namespace cg = cooperative_groups;

#define LAS __attribute__((address_space(3)))
typedef unsigned short bf16_t;
typedef short bf16x8 __attribute__((ext_vector_type(8)));
typedef float f32x4 __attribute__((ext_vector_type(4)));
typedef unsigned u32x4 __attribute__((ext_vector_type(4)));
typedef unsigned u32x2 __attribute__((ext_vector_type(2)));

constexpr int D = 1024, LP = 16384, NSEQ = 128, LS = 4, RS = NSEQ * LS, R = LP + RS;
constexpr int CPAD = 256, MODN = 12288;
constexpr int NQKV = 1536, GLAN = 3088, GLANP = 3328, DFF = 4096;
constexpr float ALPHA = 1.4142135623730951f;
constexpr float LN_EPS = 1e-5f;
constexpr int NPH = 19;
constexpr int LDS_BYTES = 131072 + 1024;

constexpr size_t O_Y = 0, O_KP = 17301504, O_VP = 17334272, O_GP = 17367040, O_KS = 17498112, O_VS = 21692416, O_GS = 25886720;
constexpr size_t WS_WT_AIN = 0;
constexpr size_t WS_WT_AOUT = WS_WT_AIN + (size_t)NQKV * D * 2;
constexpr size_t WS_WT_GIN = WS_WT_AOUT + (size_t)D * D * 2;
constexpr size_t WS_WT_GOUT = WS_WT_GIN + (size_t)GLANP * D * 2;
constexpr size_t WS_WT_W1 = WS_WT_GOUT + (size_t)D * D * 2;
constexpr size_t WS_WT_W2 = WS_WT_W1 + (size_t)2 * DFF * D * 2;
constexpr size_t WS_MOD = WS_WT_W2 + (size_t)2 * DFF * D * 2;
constexpr size_t WS_CMAT = WS_MOD + (size_t)CPAD * MODN * 4;
constexpr size_t WS_H = WS_CMAT + (size_t)CPAD * D * 2;
constexpr size_t WS_GST = WS_H + (size_t)R * D * 2;
constexpr size_t WS_PART = WS_GST;
constexpr size_t WS_GDEC = WS_GST + (size_t)64 * 4 * 256 * 128 * 4;
constexpr size_t WS_BIG = WS_GDEC + (size_t)64 * 4 * 128 * 4;
constexpr size_t WS_CTL = WS_BIG + (size_t)R * DFF * 2;
constexpr size_t CTL_BYTES = 16384;
constexpr size_t WS_STATS = WS_CTL + CTL_BYTES;
constexpr size_t WS_END = WS_STATS + (size_t)R * 8;

struct Params {
    const float* in[21];
    float* out;
    unsigned char* ws;
    int ph_lo, ph_hi;
};

typedef __bf16 bf16x2_t __attribute__((ext_vector_type(2)));
typedef float f32x2_t __attribute__((ext_vector_type(2)));
__device__ __forceinline__ unsigned cvt_pk_bf16(float lo, float hi) { const f32x2_t v = {lo, hi}; const bf16x2_t r = __builtin_convertvector(v, bf16x2_t); return __builtin_bit_cast(unsigned, r); }
__device__ __forceinline__ float bf2f(bf16_t b) { return __builtin_bit_cast(float, (unsigned)b << 16); }
__device__ __forceinline__ float bflo(unsigned u) { return __builtin_bit_cast(float, u << 16); }
__device__ __forceinline__ float bfhi(unsigned u) { return __builtin_bit_cast(float, u & 0xffff0000u); }
__device__ __forceinline__ int tidx() { int t = threadIdx.x; asm volatile("" : "+v"(t)); return t; }
typedef short s16x4 __attribute__((ext_vector_type(4)));
__device__ __forceinline__ bf16x8 tr_pair(const bf16_t* p0, const bf16_t* p1) {
    const s16x4 a = __builtin_amdgcn_ds_read_tr16_b64_v4i16((LAS s16x4*)p0), b = __builtin_amdgcn_ds_read_tr16_b64_v4i16((LAS s16x4*)p1);
    return (bf16x8){a[0], a[1], a[2], a[3], b[0], b[1], b[2], b[3]};
}
__device__ __forceinline__ float siluf(float x) { return x / (1.f + __expf(-x)); }
__device__ __forceinline__ float wave_sum(float v) {
#pragma unroll
    for (int o = 32; o > 0; o >>= 1) v += __shfl_xor(v, o, 64);
    return v;
}
__device__ __forceinline__ float wave_max(float v) {
#pragma unroll
    for (int o = 32; o > 0; o >>= 1) v = fmaxf(v, __shfl_xor(v, o, 64));
    return v;
}

namespace pg8 {
constexpr int BM = 256, BK = 64, HALF = 128, HTB = HALF * BK * 2, STAGE_BYTES = 8 * HTB, NXCD = 8, WGM = 8;
__host__ __device__ __forceinline__ int lds_byte(int r, int c) { const int st = (r >> 4) * 2 + (c >> 5), rr = r & 15, cc = c & 31, ob = rr * 64 + cc * 2; return st * 1024 + (ob ^ (((ob >> 9) & 1) << 5)); }
__host__ __device__ __forceinline__ void stage_rc(int b, int& Rr, int& C) { const int st = b / 1024, sb = b % 1024, swz = sb ^ (((sb >> 9) & 1) << 5); Rr = (st >> 1) * 16 + swz / 64; C = (st & 1) * 32 + (swz % 64) / 2; }
__host__ __device__ __forceinline__ int perm32(int rho) { const int n = rho >> 4, i = rho & 15; return 8 * (i >> 2) + 4 * n + (i & 3); }
struct Unit { int pm, pn, ks; };
struct Gemm { const bf16_t* A; const bf16_t* Bt; int M, N, K, Ksp; };
struct StaticOrder {
    int nM, nN, nwg, G, c;
    __host__ __device__ void init(int M, int N, int G_, int c_) { nM = M / BM; nN = N / BM; nwg = nM * nN; G = G_; c = c_; }
    __host__ __device__ bool next(int i, Unit& u) const {
        const long L = (long)i * G + c; if (L >= nwg) return false;
        int wgid = (int)L; { const int q = nwg / NXCD, r = nwg % NXCD, xcd = wgid % NXCD, off = wgid / NXCD; wgid = (xcd < r ? xcd * (q + 1) : r * (q + 1) + (xcd - r) * q) + off; }
        const int nig = WGM * nN, gid = wgid / nig, fm = gid * WGM, gsz = (nM - fm) < WGM ? (nM - fm) : WGM;
        u.pm = fm + ((wgid % nig) % gsz); u.pn = (wgid % nig) / gsz; u.ks = -1; return true;
    }
    __host__ __device__ int nextp(int i) const { Unit u; return next(i, u) ? (u.pm | (u.pn << 8)) : -1; }
    __device__ __forceinline__ void a_ready(const Unit&) const {}
    __device__ __forceinline__ void done(const Unit&) const {}
};
struct SplitOrder {
    StaticOrder P; int nN, nsplit, nsu;
    __host__ __device__ void init(int N, int nsplit_, int G_, int c_) { P.init(LP, N, G_, c_); nN = N / BM; nsplit = nsplit_; nsu = 2 * nN * nsplit; }
    __host__ __device__ bool next(int i, Unit& u) const {
        const long L = (long)i * P.G + P.c;
        if (L < P.nwg) return P.next(i, u);
        const int j = (int)(L - P.nwg); if (j >= nsu) return false;
        const int tile = j / nsplit; u.ks = j - tile * nsplit; u.pm = LP / BM + (tile & 1); u.pn = tile >> 1; return true;
    }
    __host__ __device__ int nextp(int i) const {
        const long L = (long)i * P.G + P.c;
        if (L < P.nwg) return P.nextp(i);
        const int j = (int)(L - P.nwg); if (j >= nsu) return -1;
        const int tile = j / nsplit;
        return (LP / BM + (tile & 1)) | ((tile >> 1) << 8) | ((j - tile * nsplit + 1) << 16);
    }
    __device__ __forceinline__ void a_ready(const Unit&) const {}
    __device__ __forceinline__ void done(const Unit&) const {}
};

struct EpiF32 {
    static constexpr bool PERM = false;
    float* C; int ldc; const float* bias;
    __device__ __forceinline__ void operator()(const f32x4 (&acc)[2][2][4][2], const Unit& u, int wr, int wc, int fr, int fq) const {
        const int row0 = u.pm * BM + wr * 64 + fr, col0 = u.pn * BM + wc * 32 + 4 * fq;
        f32x4 bv[2][2];
#pragma unroll
        for (int bj = 0; bj < 2; ++bj)
#pragma unroll
            for (int n = 0; n < 2; ++n) bv[bj][n] = *(const f32x4*)(bias + col0 + bj * HALF + n * 16);
#pragma unroll
        for (int ai = 0; ai < 2; ++ai)
#pragma unroll
            for (int m = 0; m < 4; ++m) { float* rowp = C + (size_t)(row0 + ai * HALF + m * 16) * ldc + col0;
#pragma unroll
                for (int bj = 0; bj < 2; ++bj)
#pragma unroll
                    for (int n = 0; n < 2; ++n) *(f32x4*)(rowp + bj * HALF + n * 16) = acc[ai][bj][m][n] + bv[bj][n]; }
    }
};
struct EpiBf16 {
    static constexpr bool PERM = true;
    bf16_t* O; int ldc; int act;
    __device__ __forceinline__ void operator()(const f32x4 (&acc)[2][2][4][2], const Unit& u, int wr, int wc, int fr, int fq) const {
        const int row0 = u.pm * BM + wr * 64 + fr, col0 = u.pn * BM + wc * 32 + 8 * fq;
#pragma unroll
        for (int ai = 0; ai < 2; ++ai)
#pragma unroll
            for (int m = 0; m < 4; ++m) { bf16_t* rowp = O + (size_t)(row0 + ai * HALF + m * 16) * ldc + col0;
#pragma unroll
                for (int bj = 0; bj < 2; ++bj) { f32x4 v0 = acc[ai][bj][m][0], v1 = acc[ai][bj][m][1];
                    if (act) {
#pragma unroll
                        for (int e = 0; e < 4; ++e) { float a = fmaxf(v0[e], 0.f), b = fmaxf(v1[e], 0.f); v0[e] = a * a; v1[e] = b * b; } }
                    u32x4 o; o[0] = cvt_pk_bf16(v0[0], v0[1]); o[1] = cvt_pk_bf16(v0[2], v0[3]); o[2] = cvt_pk_bf16(v1[0], v1[1]); o[3] = cvt_pk_bf16(v1[2], v1[3]);
                    *(u32x4*)(rowp + bj * HALF) = o; } }
    }
};
struct EpiResid {
    static constexpr bool PERM = false;
    float* Y; const float* X0; const float* X1; const float* gate; float* part; float* dry; const float* lg; const float* lb; const float* stats;
    __device__ __forceinline__ void operator()(const f32x4 (&acc)[2][2][4][2], const Unit& u, int wr, int wc, int fr, int fq) const {
        const int row0 = u.pm * BM + wr * 64 + fr, col0 = u.pn * BM + wc * 32 + 4 * fq;
        if (u.ks >= 0) {
            float* pb = part + ((size_t)u.ks * RS + (row0 - LP)) * D + col0;
#pragma unroll
            for (int ai = 0; ai < 2; ++ai)
#pragma unroll
                for (int m = 0; m < 4; ++m)
#pragma unroll
                    for (int bj = 0; bj < 2; ++bj)
#pragma unroll
                        for (int n = 0; n < 2; ++n) *(f32x4*)(pb + (size_t)(ai * HALF + m * 16) * D + bj * HALF + n * 16) = acc[ai][bj][m][n];
            return;
        }
#pragma unroll
        for (int bj = 0; bj < 2; ++bj)
#pragma unroll
            for (int n = 0; n < 2; ++n) {
                const int col = col0 + bj * HALF + n * 16;
                const f32x4 g = *(const f32x4*)(gate + col);
                f32x4 lgv = (f32x4){1.f, 1.f, 1.f, 1.f}, lbv = (f32x4){0.f, 0.f, 0.f, 0.f};
                if (lg) { lgv = *(const f32x4*)(lg + col); lbv = *(const f32x4*)(lb + col); }
#pragma unroll
                for (int r8 = 0; r8 < 8; ++r8) {
                    const int row = row0 + (r8 >> 2) * HALF + (r8 & 3) * 16;
                    f32x4 x = *(const f32x4*)(X0 + (size_t)row * D + col);
                    if (lg) { const float2 st = *(const float2*)(stats + 2 * (size_t)row); x = (x - st.x) * st.y * lgv + lbv; }
                    float* yr = dry ? dry + (size_t)(row & 4095) * D : Y + (size_t)row * D;
                    *(f32x4*)(yr + col) = x * ALPHA + g * acc[r8 >> 2][bj][r8 & 3][n]; } }
    }
};

template <class Epi, class Sched>
__device__ __forceinline__ void gemm_phase(LAS unsigned char* lds, const Gemm g, const Sched& S, const Epi& E) {
    const int tid = tidx(), wid = __builtin_amdgcn_readfirstlane(tid >> 6), lane = tid & 63, wr = wid >> 2, wc = wid & 3, fr = lane & 15, fq = lane >> 4;
    const int K = g.K;
    unsigned voffA[2], voffB[2];
#pragma unroll
    for (int i = 0; i < 2; ++i) { int Rr, C; stage_rc(tid * 16 + i * 8192, Rr, C); const int Rb = Epi::PERM ? ((Rr & ~31) + perm32(Rr & 31)) : Rr;
        voffA[i] = (unsigned)(Rr * K + C) * 2u; voffB[i] = (unsigned)(Rb * K + C) * 2u; }
    const size_t kstep = (size_t)(BK * 2);
    const size_t hstep = (size_t)HALF * K * 2;
    const size_t tstep = 2 * hstep;
    const unsigned ldsw = (unsigned)wid * 1024u;
    const int aoff = lds_byte(wr * 64 + fr, fq * 8), boff = lds_byte(wc * 32 + fr, fq * 8);
#define PG8_SA(b, h) (((b) * 2 + (h)) * HTB)
#define PG8_SB(b, h) ((4 + (b) * 2 + (h)) * HTB)
#define PG8_STAGE(bufoff, gbase, voff) do { _Pragma("unroll") for (int _i = 0; _i < 2; ++_i) \
        __builtin_amdgcn_global_load_lds((const unsigned*)((const char*)(gbase) + (voff)[_i]), (LAS unsigned*)(lds + (bufoff) + ldsw + _i * 8192), 16, 0, 0); } while (0)
#define PG8_LDA(dst, b, h) do { _Pragma("unroll") for (int m = 0; m < 4; ++m) _Pragma("unroll") for (int k = 0; k < 2; ++k) dst[m][k] = *(const LAS bf16x8*)(lds + PG8_SA(b, h) + aoff + m * 2048 + k * 1024); } while (0)
#define PG8_LDB(dst, b, h) do { _Pragma("unroll") for (int n = 0; n < 2; ++n) _Pragma("unroll") for (int k = 0; k < 2; ++k) dst[n][k] = *(const LAS bf16x8*)(lds + PG8_SB(b, h) + boff + n * 2048 + k * 1024); } while (0)
#define PG8_MMA(ai, bj, At, Bt) do { __builtin_amdgcn_s_setprio(1); _Pragma("unroll") for (int m = 0; m < 4; ++m) _Pragma("unroll") for (int n = 0; n < 2; ++n) _Pragma("unroll") for (int k = 0; k < 2; ++k) \
        acc[ai][bj][m][n] = __builtin_amdgcn_mfma_f32_16x16x32_bf16(Bt[n][k], At[m][k], acc[ai][bj][m][n], 0, 0, 0); __builtin_amdgcn_s_setprio(0); } while (0)
#define PG8_WAIT_V(n) asm volatile("s_waitcnt vmcnt(" #n ")" ::: "memory")
#define PG8_WAIT_L(n) asm volatile("s_waitcnt lgkmcnt(" #n ")" ::: "memory")
#define PG8_BAR __builtin_amdgcn_s_barrier()
#define PG8_SCHED __builtin_amdgcn_sched_barrier(0)
    Unit cur, nxt; int ui = 0;
    { const int pk = S.nextp(0); if (pk < 0) return; cur.pm = pk & 255; cur.pn = (pk >> 8) & 255; cur.ks = (pk >> 16) - 1; }
    f32x4 acc[2][2][4][2];
#pragma unroll
    for (int a = 0; a < 2; ++a)
#pragma unroll
        for (int b = 0; b < 2; ++b)
#pragma unroll
            for (int m = 0; m < 4; ++m)
#pragma unroll
                for (int n = 0; n < 2; ++n) acc[a][b][m][n] = (f32x4){0.f, 0.f, 0.f, 0.f};
    bf16x8 At[4][2], B0[2][2], B1[2][2];
    const size_t ksb = (size_t)g.Ksp * 2;
    const char* cA = (const char*)g.A + (size_t)cur.pm * tstep + (cur.ks < 0 ? (size_t)0 : cur.ks * ksb); const char* cB = (const char*)g.Bt + (size_t)cur.pn * tstep + (cur.ks < 0 ? (size_t)0 : cur.ks * ksb);
    int nt = (cur.ks < 0 ? K : g.Ksp) / BK;
    S.a_ready(cur);
    PG8_STAGE(PG8_SB(0, 0), cB, voffB); PG8_STAGE(PG8_SA(0, 0), cA, voffA); PG8_STAGE(PG8_SB(0, 1), cB + hstep, voffB); PG8_STAGE(PG8_SA(0, 1), cA + hstep, voffA);
    if (wr == 1) PG8_BAR;
    PG8_WAIT_V(4); PG8_BAR;
    PG8_STAGE(PG8_SB(1, 0), cB + kstep, voffB); PG8_STAGE(PG8_SA(1, 0), cA + kstep, voffA); PG8_STAGE(PG8_SB(1, 1), cB + hstep + kstep, voffB);
    PG8_WAIT_V(6); PG8_BAR;
    for (;;) {
        const int npk = S.nextp(ui + 1); const bool has_next = npk >= 0; nxt.pm = npk & 255; nxt.pn = (npk >> 8) & 255; nxt.ks = (npk >> 16) - 1;
        const size_t nko = (has_next && nxt.ks >= 0) ? nxt.ks * ksb : (size_t)0;
        const char* nA = has_next ? (const char*)g.A + (size_t)nxt.pm * tstep + nko : cA; const char* nB = has_next ? (const char*)g.Bt + (size_t)nxt.pn * tstep + nko : cB;
        for (int t = 0; t < nt; t += 2) {
            const bool last = (t == nt - 2);
            const char* a1 = cA + (size_t)(t + 1) * kstep;
            const char* a2 = last ? nA : cA + (size_t)(t + 2) * kstep; const char* b2 = last ? nB : cB + (size_t)(t + 2) * kstep;
            const char* a3 = a2 + kstep; const char* b3 = b2 + kstep;
            if (last && has_next) S.a_ready(nxt);
            PG8_LDB(B0, 0, 0); PG8_SCHED; PG8_LDA(At, 0, 0); PG8_STAGE(PG8_SA(1, 1), a1 + hstep, voffA);
            PG8_WAIT_L(8); PG8_BAR; PG8_WAIT_L(0); PG8_MMA(0, 0, At, B0); PG8_BAR; PG8_SCHED;
            PG8_LDB(B1, 0, 1); PG8_STAGE(PG8_SB(0, 0), b2, voffB);
            PG8_BAR; PG8_WAIT_L(0); PG8_MMA(0, 1, At, B1); PG8_BAR;
            PG8_LDA(At, 0, 1); PG8_STAGE(PG8_SA(0, 0), a2, voffA);
            PG8_BAR; PG8_WAIT_L(0); PG8_MMA(1, 0, At, B0); PG8_BAR; PG8_SCHED;
            PG8_STAGE(PG8_SB(0, 1), b2 + hstep, voffB);
            PG8_WAIT_V(6); PG8_BAR; PG8_MMA(1, 1, At, B1); PG8_BAR;
            PG8_LDB(B0, 1, 0); PG8_SCHED; PG8_LDA(At, 1, 0); PG8_STAGE(PG8_SA(0, 1), a2 + hstep, voffA);
            PG8_WAIT_L(8); PG8_BAR; PG8_WAIT_L(0); PG8_MMA(0, 0, At, B0); PG8_BAR; PG8_SCHED;
            PG8_LDB(B1, 1, 1); PG8_STAGE(PG8_SB(1, 0), b3, voffB);
            PG8_BAR; PG8_WAIT_L(0); PG8_MMA(0, 1, At, B1); PG8_BAR;
            PG8_LDA(At, 1, 1); PG8_STAGE(PG8_SA(1, 0), a3, voffA);
            PG8_BAR; PG8_WAIT_L(0); PG8_MMA(1, 0, At, B0); PG8_BAR; PG8_SCHED;
            PG8_STAGE(PG8_SB(1, 1), b3 + hstep, voffB);
            PG8_WAIT_V(6); PG8_BAR; PG8_MMA(1, 1, At, B1); PG8_BAR;
        }
        E(acc, cur, wr, wc, fr, fq); S.done(cur);
        if (!has_next) break;
#pragma unroll
        for (int a = 0; a < 2; ++a)
#pragma unroll
            for (int b = 0; b < 2; ++b)
#pragma unroll
                for (int m = 0; m < 4; ++m)
#pragma unroll
                    for (int n = 0; n < 2; ++n) acc[a][b][m][n] = (f32x4){0.f, 0.f, 0.f, 0.f};
        cur = nxt; cA = nA; cB = nB; ++ui; nt = (cur.ks < 0 ? K : g.Ksp) / BK;
    }
    PG8_WAIT_V(0);
    if (wr == 0) PG8_BAR;
    PG8_BAR;
#undef PG8_SA
#undef PG8_SB
#undef PG8_STAGE
#undef PG8_LDA
#undef PG8_LDB
#undef PG8_MMA
#undef PG8_WAIT_V
#undef PG8_WAIT_L
#undef PG8_BAR
#undef PG8_SCHED
}
}

__device__ __forceinline__ void transpose_convert(const float* __restrict__ W, bf16_t* __restrict__ Wt, int K, int N, int Npad, float* tile, int wg, int nwg) {
    const int tid = tidx();
    const int tn_n = Npad / 256, tk_n = K / 64, ntl = tn_n * tk_n;
    for (int t = wg; t < ntl; t += nwg) {
        const int tn = t % tn_n, tk = t / tn_n;
        float v[32];
#pragma unroll
        for (int e = 0; e < 32; ++e) { const int idx = e * 512 + tid, r = idx >> 8, c = idx & 255; const int col = tn * 256 + c;
            v[e] = col < N ? W[(size_t)(tk * 64 + r) * N + col] : 0.f; }
#pragma unroll
        for (int e = 0; e < 32; ++e) { const int idx = e * 512 + tid, r = idx >> 8, c = idx & 255; tile[r * 257 + c] = v[e]; }
        __syncthreads();
#pragma unroll
        for (int e = 0; e < 4; ++e) { const int ch = e * 512 + tid, n = ch >> 3, kc = ch & 7;
            u32x4 o;
#pragma unroll
            for (int j = 0; j < 4; ++j) o[j] = cvt_pk_bf16(tile[(kc * 8 + 2 * j) * 257 + n], tile[(kc * 8 + 2 * j + 1) * 257 + n]);
            *(u32x4*)(Wt + (size_t)(tn * 256 + n) * K + tk * 64 + kc * 8) = o; }
        __syncthreads();
    }
}

__device__ __forceinline__ void phase_prep(const Params& p, unsigned char* shm, int wg, int nwg, int part) {
    float* tile = (float*)shm;
    unsigned char* ws = p.ws;
    if (part == 0) {
        for (int m = 0; m < 4; ++m)
            transpose_convert(p.in[7] + (size_t)m * D * 3072, (bf16_t*)(ws + WS_BIG) + (size_t)m * 3072 * D, D, 3072, 3072, tile, wg, nwg);
        transpose_convert(p.in[11], (bf16_t*)(ws + WS_WT_AIN), D, NQKV, NQKV, tile, wg, nwg);
        transpose_convert(p.in[12], (bf16_t*)(ws + WS_WT_AOUT), D, D, D, tile, wg, nwg);
        bf16_t* cm = (bf16_t*)(ws + WS_CMAT);
        for (int idx = wg * 512 + tidx(); idx < CPAD * D; idx += nwg * 512) {
            const int r = idx >> 10, c = idx & 1023;
            float v = 0.f;
            if (r == 0) v = siluf(p.in[5][c]); else if (r <= NSEQ) v = siluf(p.in[6][(size_t)(r - 1) * D + c]);
            cm[idx] = (bf16_t)(cvt_pk_bf16(v, 0.f) & 0xffffu);
        }
    } else if (part == 1) {
        for (int l = 0; l < 2; ++l) {
            transpose_convert(p.in[19] + (size_t)l * D * DFF, (bf16_t*)(ws + WS_WT_W1) + (size_t)l * DFF * D, D, DFF, DFF, tile, wg, nwg);
            transpose_convert(p.in[20] + (size_t)l * DFF * D, (bf16_t*)(ws + WS_WT_W2) + (size_t)l * D * DFF, DFF, D, D, tile, wg, nwg);
        }
    } else {
        transpose_convert(p.in[14], (bf16_t*)(ws + WS_WT_GIN), D, GLAN, GLANP, tile, wg, nwg);
        transpose_convert(p.in[18], (bf16_t*)(ws + WS_WT_GOUT), D, D, D, tile, wg, nwg);
    }
}

__device__ __forceinline__ int crow_of(int row) { return row < LP ? 0 : 1 + ((row - LP) >> 2); }

__device__ __forceinline__ void phase_mod0(const Params& p, int wg, int nwg) {
    const int tid = tidx(), lane = tid & 63, wave = tid >> 6;
    const float* mod = (const float*)(p.ws + WS_MOD);
    bf16_t* H = (bf16_t*)(p.ws + WS_H);
    f32x4 sh0[4], sc0[4];
#pragma unroll
    for (int k = 0; k < 4; ++k) { sh0[k] = *(const f32x4*)(mod + k * 256 + lane * 4); sc0[k] = *(const f32x4*)(mod + 1024 + k * 256 + lane * 4) + 1.f; }
#pragma unroll 2
    for (int row = wg * 8 + wave; row < R; row += nwg * 8) {
        const float* xr = row < LP ? p.in[0] + (size_t)row * D : p.in[1] + (size_t)(row - LP) * D;
        const float* mr = mod + (size_t)crow_of(row) * MODN;
#pragma unroll
        for (int k = 0; k < 4; ++k) { const int col = k * 256 + lane * 4;
            const f32x4 x = *(const f32x4*)(xr + col);
            f32x4 sh = sh0[k], sc = sc0[k];
            if (row >= LP) { sh = *(const f32x4*)(mr + col); sc = *(const f32x4*)(mr + 1024 + col) + 1.f; }
            const f32x4 h = x * sc + sh;
            u32x2 o; o[0] = cvt_pk_bf16(h[0], h[1]); o[1] = cvt_pk_bf16(h[2], h[3]);
            *(u32x2*)(H + (size_t)row * D + col) = o; }
    }
}

__device__ __forceinline__ void phase_ln(const Params& p, int lnidx, int nset, int nsplit, int gset, int wg, int nwg, bool dry = false) {
    const int tid = tidx(), lane = tid & 63, wave = tid >> 6;
    const float* mod = (const float*)(p.ws + WS_MOD);
    bf16_t* H = (bf16_t*)(p.ws + WS_H);
    float* stats = (float*)(p.ws + WS_STATS);
    float* Y = p.out;
    const float* g = p.in[9] + lnidx * D; const float* b = p.in[10] + lnidx * D;
    f32x4 gv[4], bv[4];
#pragma unroll
    for (int k = 0; k < 4; ++k) { gv[k] = *(const f32x4*)(g + k * 256 + lane * 4); bv[k] = *(const f32x4*)(b + k * 256 + lane * 4); }
    f32x4 gm[4], bm[4];
#pragma unroll
    for (int k = 0; k < 4; ++k) { gm[k] = gv[k]; bm[k] = bv[k];
        if (nset >= 0) { const f32x4 sh = *(const f32x4*)(mod + nset * 3072 + k * 256 + lane * 4), sc = *(const f32x4*)(mod + nset * 3072 + 1024 + k * 256 + lane * 4) + 1.f;
            gm[k] = gv[k] * sc; bm[k] = bv[k] * sc + sh; } }
    const int rstep = nwg * 8;
    f32x4 nv[4];
    { const int row0 = wg * 8 + wave;
#pragma unroll
      for (int k = 0; k < 4; ++k) nv[k] = *(const f32x4*)(Y + (size_t)row0 * D + k * 256 + lane * 4); }
    for (int row = wg * 8 + wave; row < R; row += rstep) {
        float* yr = Y + (size_t)row * D;
        f32x4 v[4]; float s = 0.f;
        if (row < LP) {
#pragma unroll
            for (int k = 0; k < 4; ++k) v[k] = nv[k];
            if (row + rstep < LP) {
#pragma unroll
                for (int k = 0; k < 4; ++k) nv[k] = *(const f32x4*)(yr + (size_t)rstep * D + k * 256 + lane * 4); }
        } else {
            const float* pr = (const float*)(p.ws + WS_PART) + (size_t)(row - LP) * D;
            const float* gr = mod + (size_t)crow_of(row) * MODN + gset * 3072 + 2048;
            float mu0 = 0.f, rs0 = 1.f;
            if (lnidx > 0) { const float2 st = *(const float2*)(stats + 2 * (size_t)row); mu0 = st.x; rs0 = st.y; }
#pragma unroll
            for (int k = 0; k < 4; ++k) { const int col = k * 256 + lane * 4;
                f32x4 a = *(const f32x4*)(pr + col);
                for (int sp = 1; sp < nsplit; ++sp) a = a + *(const f32x4*)(pr + (size_t)sp * RS * D + col);
                f32x4 x;
                if (lnidx == 0) x = *(const f32x4*)(p.in[1] + (size_t)(row - LP) * D + col);
                else x = (*(const f32x4*)(yr + col) - mu0) * rs0 * *(const f32x4*)(g - D + col) + *(const f32x4*)(b - D + col);
                v[k] = x * ALPHA + *(const f32x4*)(gr + col) * a;
                if (nset >= 0 && !dry) *(f32x4*)(yr + col) = v[k]; }
        }
#pragma unroll
        for (int k = 0; k < 4; ++k) s += v[k][0] + v[k][1] + v[k][2] + v[k][3];
        const float mu = wave_sum(s) * (1.f / D);
        float q = 0.f;
#pragma unroll
        for (int k = 0; k < 4; ++k) { const f32x4 d = v[k] - mu; q += d[0] * d[0] + d[1] * d[1] + d[2] * d[2] + d[3] * d[3]; }
        const float rstd = rsqrtf(wave_sum(q) * (1.f / D) + LN_EPS);
        if (nset >= 0 && lane == 0 && !dry) *(float2*)(stats + 2 * (size_t)row) = make_float2(mu, rstd);
        const float* mr = mod + (size_t)crow_of(row) * MODN + (nset >= 0 ? nset * 3072 : 0);
#pragma unroll
        for (int k = 0; k < 4; ++k) { const int col = k * 256 + lane * 4;
            const f32x4 x = (v[k] - mu) * rstd * gv[k] + bv[k];
            if (nset < 0) *(f32x4*)(yr + col) = x;
            else {
                f32x4 h;
                if (row < LP) h = (v[k] - mu) * rstd * gm[k] + bm[k];
                else { const f32x4 sh = *(const f32x4*)(mr + col), sc = *(const f32x4*)(mr + 1024 + col); h = x * (sc + 1.f) + sh; }
                u32x2 o; o[0] = cvt_pk_bf16(h[0], h[1]); o[1] = cvt_pk_bf16(h[2], h[3]);
                *(u32x2*)((dry ? (bf16_t*)(p.ws + WS_BIG + (size_t)80 * 1024 * 1024) : H) + (size_t)row * D + col) = o; } }
    }
}

__device__ __forceinline__ void attn_prompt_unit(const Params& p, unsigned char* shm, int unit) {
    const int tid = tidx(), lane = tid & 63, w = tid >> 6, c = lane & 15, q = lane >> 4;
    const int nb = unit >> 2, hk = unit & 3;
    const bf16_t* QKV = (const bf16_t*)(p.ws + WS_BIG);
    bf16_t* O = (bf16_t*)(p.ws + WS_H);
    bf16_t* Ks = (bf16_t*)shm;
    bf16_t* Vs = (bf16_t*)(shm + 36864);
    const int rbase = nb * 128 - 128;
#pragma unroll
    for (int i = 0; i < 4; ++i) { const int ch = tid + i * 512, s = ch >> 3, cc = ch & 7; const int grow = rbase + s;
        u32x4 v = (u32x4){0u, 0u, 0u, 0u};
        if (grow >= 0) v = *(const u32x4*)(QKV + (size_t)grow * NQKV + 1024 + hk * 64 + cc * 8);
        *(u32x4*)(Ks + s * 72 + cc * 8) = v; }
#pragma unroll
    for (int i = 0; i < 4; ++i) { const int ch = tid + i * 512, sr = ch >> 3, cc = ch & 7; const int grow = rbase + sr;
        u32x4 v = (u32x4){0u, 0u, 0u, 0u};
        if (grow >= 0) v = *(const u32x4*)(QKV + (size_t)grow * NQKV + 1280 + hk * 64 + cc * 8);
        *(u32x4*)(Vs + sr * 72 + cc * 8) = v; }
    if (nb == 127) {
        float* ok = p.out + O_KP; float* ov = p.out + O_VP;
        for (int idx = tid; idx < 128 * 64; idx += 512) { const int s = idx >> 6, d = idx & 63; const size_t row = (size_t)(LP - 128 + s);
            ok[(s * 4 + hk) * 64 + d] = bf2f(QKV[row * NQKV + 1024 + hk * 64 + d]);
            ov[(s * 4 + hk) * 64 + d] = bf2f(QKV[row * NQKV + 1280 + hk * 64 + d]); }
    }
    __syncthreads();
#pragma unroll 1
    for (int it = 0; it < 4; ++it) {
        const int task = w + 8 * (it >> 1), tt = it & 1;
        const int hq = hk * 4 + (task >> 2), w0 = (task & 3) * 32;
        const float slope = exp2f(-0.5f * (float)(hq + 1));
        const float sink = p.in[13][hq];
        bf16x8 qf[2];
#pragma unroll
        for (int kk = 0; kk < 2; ++kk) qf[kk] = *(const bf16x8*)(QKV + (size_t)(nb * 128 + w0 + tt * 16 + c) * NQKV + hq * 64 + kk * 32 + q * 8);
        f32x4 sc[10];
#pragma unroll
        for (int st = 0; st < 10; ++st) {
            sc[st] = (f32x4){0.f, 0.f, 0.f, 0.f};
#pragma unroll
            for (int kk = 0; kk < 2; ++kk) {
                const bf16x8 kf = *(const bf16x8*)(Ks + (w0 + st * 16 + c) * 72 + kk * 32 + q * 8);
                sc[st] = __builtin_amdgcn_mfma_f32_16x16x32_bf16(kf, qf[kk], sc[st], 0, 0, 0);
            }
        }
        float mx = sink;
        const int tq = w0 + tt * 16 + c;
#pragma unroll
        for (int st = 0; st < 10; ++st)
#pragma unroll
            for (int e = 0; e < 4; ++e) {
                const int s = w0 + st * 16 + q * 4 + e, dist = tq + 128 - s;
                const bool valid = dist >= 0 && dist <= 128 && (nb > 0 || s >= 128);
                const float v = valid ? sc[st][e] * 0.125f - slope * (float)dist : -INFINITY;
                sc[st][e] = v; mx = fmaxf(mx, v);
            }
        mx = fmaxf(mx, __shfl_xor(mx, 16, 64)); mx = fmaxf(mx, __shfl_xor(mx, 32, 64));
        float ssum = 0.f;
#pragma unroll
        for (int st = 0; st < 10; ++st)
#pragma unroll
            for (int e = 0; e < 4; ++e) { const float pv = __expf(sc[st][e] - mx); sc[st][e] = pv; ssum += pv; }
        ssum += __shfl_xor(ssum, 16, 64); ssum += __shfl_xor(ssum, 32, 64);
        const float linv = 1.f / (ssum + __expf(sink - mx));
        f32x4 o[4];
#pragma unroll
        for (int dt = 0; dt < 4; ++dt) o[dt] = (f32x4){0.f, 0.f, 0.f, 0.f};
#pragma unroll
        for (int pp = 0; pp < 5; ++pp) {
            u32x4 pu; pu[0] = cvt_pk_bf16(sc[2 * pp][0], sc[2 * pp][1]); pu[1] = cvt_pk_bf16(sc[2 * pp][2], sc[2 * pp][3]);
            pu[2] = cvt_pk_bf16(sc[2 * pp + 1][0], sc[2 * pp + 1][1]); pu[3] = cvt_pk_bf16(sc[2 * pp + 1][2], sc[2 * pp + 1][3]);
            const bf16x8 pf = __builtin_bit_cast(bf16x8, pu);
#pragma unroll
            for (int dt = 0; dt < 4; ++dt) {
                const bf16_t* vp = Vs + (w0 + 32 * pp + 4 * q + (c >> 2)) * 72 + dt * 16 + 4 * (c & 3);
                const bf16x8 vf = tr_pair(vp, vp + 16 * 72);
                o[dt] = __builtin_amdgcn_mfma_f32_16x16x32_bf16(vf, pf, o[dt], 0, 0, 0);
            }
        }
#pragma unroll
        for (int dt = 0; dt < 4; ++dt) {
            const f32x4 v = o[dt] * linv;
            u32x2 u; u[0] = cvt_pk_bf16(v[0], v[1]); u[1] = cvt_pk_bf16(v[2], v[3]);
            *(u32x2*)(O + (size_t)(nb * 128 + w0 + tt * 16 + c) * D + hq * 64 + dt * 16 + q * 4) = u;
        }
    }
    __syncthreads();
}

__device__ __forceinline__ void attn_sample_unit(const Params& p, unsigned char* shm, int unit) {
    const int tid = tidx(), lane = tid & 63, w = tid >> 6;
    const int b = unit >> 2, hk = unit & 3;
    const bf16_t* QKV = (const bf16_t*)(p.ws + WS_BIG);
    bf16_t* O = (bf16_t*)(p.ws + WS_H);
    float* Kf = (float*)shm;
    float* Vf = Kf + 132 * 65;
    float* Qf = Vf + 132 * 65;
    float* P = Qf + 16 * 64;
    const float* ck = p.in[2]; const float* cv = p.in[3];
    float* ok = p.out + O_KS; float* ov = p.out + O_VS;
    for (int idx = tid; idx < 128 * 64; idx += 512) { const int j = idx >> 6, d = idx & 63;
        const size_t src = ((size_t)(b * 128 + j) * 4 + hk) * 64 + d;
        const float kv = ck[src], vv = cv[src];
        Kf[j * 65 + d] = kv; Vf[j * 65 + d] = vv;
        if (j >= 4) { const size_t dst = ((size_t)(b * 128 + j - 4) * 4 + hk) * 64 + d; ok[dst] = kv; ov[dst] = vv; } }
    if (tid < 256) { const int t = tid >> 6, d = tid & 63; const size_t row = (size_t)(LP + b * 4 + t);
        const float kv = bf2f(QKV[row * NQKV + 1024 + hk * 64 + d]), vv = bf2f(QKV[row * NQKV + 1280 + hk * 64 + d]);
        Kf[(128 + t) * 65 + d] = kv; Vf[(128 + t) * 65 + d] = vv;
        const size_t dst = ((size_t)(b * 128 + 124 + t) * 4 + hk) * 64 + d; ok[dst] = kv; ov[dst] = vv; }
    for (int idx = tid; idx < 16 * 64; idx += 512) { const int row = idx >> 6, d = idx & 63, g = row >> 2, t = row & 3;
        Qf[idx] = bf2f(QKV[(size_t)(LP + b * 4 + t) * NQKV + (hk * 4 + g) * 64 + d]); }
    __syncthreads();
    for (int idx = tid; idx < 16 * 132; idx += 512) { const int row = idx / 132, j = idx - row * 132, g = row >> 2, t = row & 3;
        const int dist = t + 128 - j;
        float v = -INFINITY;
        if (dist >= 0 && dist <= 128) {
            float a = 0.f;
#pragma unroll 16
            for (int d = 0; d < 64; ++d) a += Qf[row * 64 + d] * Kf[j * 65 + d];
            v = a * 0.125f - exp2f(-0.5f * (float)(hk * 4 + g + 1)) * (float)dist; }
        P[row * 136 + j] = v; }
    __syncthreads();
#pragma unroll
    for (int rr = 0; rr < 2; ++rr) { const int row = w * 2 + rr, g = row >> 2;
        const float sink = p.in[13][hk * 4 + g];
        float v0 = P[row * 136 + lane], v1 = P[row * 136 + 64 + lane], v2 = lane < 4 ? P[row * 136 + 128 + lane] : -INFINITY;
        const float m = fmaxf(wave_max(fmaxf(fmaxf(v0, v1), v2)), sink);
        v0 = __expf(v0 - m); v1 = __expf(v1 - m); v2 = __expf(v2 - m);
        const float inv = 1.f / (wave_sum(v0 + v1 + v2) + __expf(sink - m));
        P[row * 136 + lane] = v0 * inv; P[row * 136 + 64 + lane] = v1 * inv; if (lane < 4) P[row * 136 + 128 + lane] = v2 * inv; }
    __syncthreads();
#pragma unroll
    for (int rr = 0; rr < 2; ++rr) { const int idx = tid + rr * 512, row = idx >> 6, d = idx & 63, g = row >> 2, t = row & 3;
        float a = 0.f;
        for (int j = 0; j < 132; ++j) a += P[row * 136 + j] * Vf[j * 65 + d];
        O[(size_t)(LP + b * 4 + t) * D + (hk * 4 + g) * 64 + d] = (bf16_t)(cvt_pk_bf16(a, 0.f) & 0xffffu); }
    __syncthreads();
}

constexpr int G_QD = 0;
constexpr int G_KD = 17408;
constexpr int G_KDT = 34816;
constexpr int G_VT = 53248;
constexpr int G_AM = 90112;
constexpr int G_GD = 99328;
constexpr int G_EBC = 103424;
constexpr int G_SEG = 103936;
constexpr int G_RED = 105984;

__device__ __forceinline__ float log_sigmoid(float z) { return fminf(z, 0.f) - __logf(1.f + __expf(-fabsf(z))); }

template <bool FULL>
__device__ __forceinline__ float gla_preamble(const bf16_t* PROJ, unsigned char* shm, int r0, int h, const float (&wup)[16], float bg) {
    const int tid = tidx();
    bf16_t* QD = (bf16_t*)(shm + G_QD); bf16_t* KD = (bf16_t*)(shm + G_KD); bf16_t* KDT = (bf16_t*)(shm + G_KDT); bf16_t* VT = (bf16_t*)(shm + G_VT);
    float* GD = (float*)(shm + G_GD); float* EBC = (float*)(shm + G_EBC); float* SEG = (float*)(shm + G_SEG);
#pragma unroll
    for (int e = 0; e < 2; ++e) { const int idx = tid + e * 512, t = idx >> 4, j = idx & 15; GD[idx] = bf2f(PROJ[(size_t)(r0 + t) * GLANP + 3072 + j]); }
    const int i = tid & 127, seg = tid >> 7;
    unsigned short kraw[16], qraw[16];
#pragma unroll
    for (int tt = 0; tt < 16; ++tt) { const size_t rr = (size_t)(r0 + seg * 16 + tt) * GLANP + h * 128 + i; kraw[tt] = PROJ[rr + 512]; if (FULL) qraw[tt] = PROJ[rr]; }
#pragma unroll
    for (int e = 0; e < 4; ++e) { const int ch = tid + e * 512, t = ch >> 5, cc = ch & 31;
        *(u32x4*)(VT + t * 264 + cc * 8) = *(const u32x4*)(PROJ + (size_t)(r0 + t) * GLANP + 1024 + h * 256 + cc * 8); }
    __syncthreads();
    float bl[16]; float run = 0.f;
#pragma unroll
    for (int tt = 0; tt < 16; ++tt) { const int t = seg * 16 + tt; float z = bg;
#pragma unroll
        for (int j = 0; j < 16; ++j) z += GD[t * 16 + j] * wup[j];
        run += log_sigmoid(z) * (1.f / 16.f); bl[tt] = run; }
    SEG[seg * 128 + i] = run;
    __syncthreads();
    float pre = 0.f, tot = 0.f;
#pragma unroll
    for (int s = 0; s < 4; ++s) { const float v = SEG[s * 128 + i]; tot += v; if (s < seg) pre += v; }
    float kdv[16];
#pragma unroll
    for (int tt = 0; tt < 16; ++tt) { const int t = seg * 16 + tt; const float bt = pre + bl[tt];
        const float kv = bf2f(kraw[tt]);
        kdv[tt] = kv * __expf(tot - bt);
        if (FULL) {
            const float qv = bf2f(qraw[tt]) * 0.08838834764831845f;
            QD[t * 136 + i] = (bf16_t)(cvt_pk_bf16(qv * __expf(bt), 0.f) & 0xffffu);
            KD[t * 136 + i] = (bf16_t)(cvt_pk_bf16(kv * __expf(-bt), 0.f) & 0xffffu);
        } }
    { u32x4 v0, v1;
      v0[0] = cvt_pk_bf16(kdv[0], kdv[1]); v0[1] = cvt_pk_bf16(kdv[2], kdv[3]); v0[2] = cvt_pk_bf16(kdv[4], kdv[5]); v0[3] = cvt_pk_bf16(kdv[6], kdv[7]);
      v1[0] = cvt_pk_bf16(kdv[8], kdv[9]); v1[1] = cvt_pk_bf16(kdv[10], kdv[11]); v1[2] = cvt_pk_bf16(kdv[12], kdv[13]); v1[3] = cvt_pk_bf16(kdv[14], kdv[15]);
      *(u32x4*)(KDT + i * 72 + seg * 16) = v0; *(u32x4*)(KDT + i * 72 + seg * 16 + 8) = v1; }
    if (seg == 0) EBC[i] = __expf(tot);
    __syncthreads();
    return tot;
}

__device__ __forceinline__ void gla_state_update(f32x4 (&S)[8][2], unsigned char* shm, int w, int c, int q) {
    const bf16_t* KDT = (const bf16_t*)(shm + G_KDT); const bf16_t* VT = (const bf16_t*)(shm + G_VT); const float* EBC = (const float*)(shm + G_EBC);
#pragma unroll
    for (int ib = 0; ib < 8; ++ib) { const f32x4 eb = *(const f32x4*)(EBC + ib * 16 + q * 4); S[ib][0] = S[ib][0] * eb; S[ib][1] = S[ib][1] * eb; }
#pragma unroll
    for (int kk = 0; kk < 2; ++kk) {
        bf16x8 vf[2];
#pragma unroll
        for (int jb = 0; jb < 2; ++jb) { const bf16_t* vp = VT + (kk * 32 + 8 * q + (c >> 2)) * 264 + w * 32 + jb * 16 + 4 * (c & 3); vf[jb] = tr_pair(vp, vp + 4 * 264); }
#pragma unroll
        for (int ib = 0; ib < 8; ++ib) { const bf16x8 kf = *(const bf16x8*)(KDT + (ib * 16 + c) * 72 + kk * 32 + q * 8);
            S[ib][0] = __builtin_amdgcn_mfma_f32_16x16x32_bf16(kf, vf[0], S[ib][0], 0, 0, 0);
            S[ib][1] = __builtin_amdgcn_mfma_f32_16x16x32_bf16(kf, vf[1], S[ib][1], 0, 0, 0); }
    }
}

__device__ __forceinline__ void gla_g1_item(const Params& p, unsigned char* shm, int item) {
    const int tid = tidx(), lane = tid & 63, w = tid >> 6, c = lane & 15, q = lane >> 4;
    const int sc = item >> 2, h = item & 3;
    const bf16_t* PROJ = (const bf16_t*)(p.ws + WS_BIG);
    float* GST = (float*)(p.ws + WS_GST); float* GDEC = (float*)(p.ws + WS_GDEC);
    float wup[16]; const int i = tid & 127;
#pragma unroll
    for (int j = 0; j < 16; ++j) wup[j] = p.in[15][j * 512 + h * 128 + i];
    const float bg = p.in[16][h * 128 + i];
    f32x4 S[8][2];
#pragma unroll
    for (int ib = 0; ib < 8; ++ib) { S[ib][0] = (f32x4){0.f, 0.f, 0.f, 0.f}; S[ib][1] = (f32x4){0.f, 0.f, 0.f, 0.f}; }
    float dec = 0.f;
#pragma unroll 1
    for (int ch = 0; ch < 4; ++ch) {
        dec += gla_preamble<false>(PROJ, shm, sc * 256 + ch * 64, h, wup, bg);
        gla_state_update(S, shm, w, c, q);
        __syncthreads();
    }
    float* dst = GST + (size_t)(sc * 4 + h) * 256 * 128;
#pragma unroll
    for (int ib = 0; ib < 8; ++ib)
#pragma unroll
        for (int jb = 0; jb < 2; ++jb) *(f32x4*)(dst + (size_t)(w * 32 + jb * 16 + c) * 128 + ib * 16 + q * 4) = S[ib][jb];
    if (tid < 128) GDEC[(sc * 4 + h) * 128 + tid] = dec;
}

__device__ __forceinline__ void gla_g2(const Params& p, int wg, int nwg) {
    float* GST = (float*)(p.ws + WS_GST); const float* GDEC = (const float*)(p.ws + WS_GDEC);
    float* og = p.out + O_GP;
    for (int idx = wg * 512 + tidx(); idx < 4 * 256 * 128; idx += nwg * 512) {
        const int h = idx >> 15, j = (idx >> 7) & 255, i = idx & 127;
        float S = 0.f;
        for (int s0 = 0; s0 < 64; s0 += 8) {
            float d[8], a[8];
#pragma unroll
            for (int k = 0; k < 8; ++k) { d[k] = GST[((size_t)((s0 + k) * 4 + h) * 256 + j) * 128 + i]; a[k] = GDEC[((s0 + k) * 4 + h) * 128 + i]; }
#pragma unroll
            for (int k = 0; k < 8; ++k) { GST[((size_t)((s0 + k) * 4 + h) * 256 + j) * 128 + i] = S; S = __expf(a[k]) * S + d[k]; }
        }
        og[(h * 128 + i) * 256 + j] = S;
    }
}

__device__ __forceinline__ void gla_g3_item(const Params& p, unsigned char* shm, int item) {
    const int tid = tidx(), lane = tid & 63, w = tid >> 6, c = lane & 15, q = lane >> 4;
    const int sc = item >> 2, h = item & 3;
    const bf16_t* PROJ = (const bf16_t*)(p.ws + WS_BIG);
    bf16_t* O = (bf16_t*)(p.ws + WS_H);
    const float* GST = (const float*)(p.ws + WS_GST);
    const bf16_t* QD = (const bf16_t*)(shm + G_QD); const bf16_t* KD = (const bf16_t*)(shm + G_KD); const bf16_t* VT = (const bf16_t*)(shm + G_VT);
    bf16_t* AM = (bf16_t*)(shm + G_AM); float* RED = (float*)(shm + G_RED);
    float wup[16]; const int i = tid & 127;
#pragma unroll
    for (int j = 0; j < 16; ++j) wup[j] = p.in[15][j * 512 + h * 128 + i];
    const float bg = p.in[16][h * 128 + i];
    f32x4 S[8][2];
    { const float* src = GST + (size_t)(sc * 4 + h) * 256 * 128;
#pragma unroll
      for (int ib = 0; ib < 8; ++ib)
#pragma unroll
          for (int jb = 0; jb < 2; ++jb) S[ib][jb] = *(const f32x4*)(src + (size_t)(w * 32 + jb * 16 + c) * 128 + ib * 16 + q * 4); }
    const f32x4 ng0 = *(const f32x4*)(p.in[17] + w * 32 + q * 4), ng1 = *(const f32x4*)(p.in[17] + w * 32 + 16 + q * 4);
#pragma unroll 1
    for (int ch = 0; ch < 4; ++ch) {
        const int r0 = sc * 256 + ch * 64;
        gla_preamble<true>(PROJ, shm, r0, h, wup, bg);
        { const int tb = w >> 1;
#pragma unroll
          for (int x = 0; x < 2; ++x) { const int sb = (w & 1) * 2 + x;
              f32x4 a = (f32x4){0.f, 0.f, 0.f, 0.f};
              if (sb <= tb) {
#pragma unroll
                  for (int kk = 0; kk < 4; ++kk) { const bf16x8 af = *(const bf16x8*)(QD + (tb * 16 + c) * 136 + kk * 32 + q * 8), bfv = *(const bf16x8*)(KD + (sb * 16 + c) * 136 + kk * 32 + q * 8);
                      a = __builtin_amdgcn_mfma_f32_16x16x32_bf16(af, bfv, a, 0, 0, 0); } }
#pragma unroll
              for (int e = 0; e < 4; ++e) { const int t = tb * 16 + q * 4 + e, s = sb * 16 + c;
                  AM[t * 72 + s] = (bf16_t)(cvt_pk_bf16(s <= t ? a[e] : 0.f, 0.f) & 0xffffu); } } }
        __syncthreads();
        f32x4 o[2][4];
#pragma unroll
        for (int jb = 0; jb < 2; ++jb)
#pragma unroll
            for (int tb = 0; tb < 4; ++tb) o[jb][tb] = (f32x4){0.f, 0.f, 0.f, 0.f};
#pragma unroll
        for (int pp = 0; pp < 4; ++pp) {
            bf16x8 sf[2];
#pragma unroll
            for (int jb = 0; jb < 2; ++jb) { u32x4 u;
                u[0] = cvt_pk_bf16(S[2 * pp][jb][0], S[2 * pp][jb][1]); u[1] = cvt_pk_bf16(S[2 * pp][jb][2], S[2 * pp][jb][3]);
                u[2] = cvt_pk_bf16(S[2 * pp + 1][jb][0], S[2 * pp + 1][jb][1]); u[3] = cvt_pk_bf16(S[2 * pp + 1][jb][2], S[2 * pp + 1][jb][3]);
                sf[jb] = __builtin_bit_cast(bf16x8, u); }
#pragma unroll
            for (int tb = 0; tb < 4; ++tb) { const bf16_t* qp = QD + (tb * 16 + c) * 136 + 32 * pp + 4 * q;
                const u32x2 a = *(const u32x2*)qp, b = *(const u32x2*)(qp + 16); u32x4 u; u[0] = a[0]; u[1] = a[1]; u[2] = b[0]; u[3] = b[1];
                const bf16x8 qf = __builtin_bit_cast(bf16x8, u);
                o[0][tb] = __builtin_amdgcn_mfma_f32_16x16x32_bf16(sf[0], qf, o[0][tb], 0, 0, 0);
                o[1][tb] = __builtin_amdgcn_mfma_f32_16x16x32_bf16(sf[1], qf, o[1][tb], 0, 0, 0); }
        }
#pragma unroll
        for (int kk = 0; kk < 2; ++kk) {
            bf16x8 vf[2];
#pragma unroll
            for (int jb = 0; jb < 2; ++jb) { const bf16_t* vp = VT + (kk * 32 + 8 * q + (c >> 2)) * 264 + w * 32 + jb * 16 + 4 * (c & 3); vf[jb] = tr_pair(vp, vp + 4 * 264); }
#pragma unroll
            for (int tb = 0; tb < 4; ++tb) { const bf16x8 af = *(const bf16x8*)(AM + (tb * 16 + c) * 72 + kk * 32 + q * 8);
                o[0][tb] = __builtin_amdgcn_mfma_f32_16x16x32_bf16(vf[0], af, o[0][tb], 0, 0, 0);
                o[1][tb] = __builtin_amdgcn_mfma_f32_16x16x32_bf16(vf[1], af, o[1][tb], 0, 0, 0); }
        }
        gla_state_update(S, shm, w, c, q);
#pragma unroll
        for (int tb = 0; tb < 4; ++tb) { float s = 0.f;
#pragma unroll
            for (int jb = 0; jb < 2; ++jb)
#pragma unroll
                for (int e = 0; e < 4; ++e) s += o[jb][tb][e] * o[jb][tb][e];
            s += __shfl_xor(s, 16, 64); s += __shfl_xor(s, 32, 64);
            if (q == 0) RED[w * 64 + tb * 16 + c] = s; }
        __syncthreads();
#pragma unroll
        for (int tb = 0; tb < 4; ++tb) { float s = 0.f;
#pragma unroll
            for (int ww = 0; ww < 8; ++ww) s += RED[ww * 64 + tb * 16 + c];
            const float rs = rsqrtf(s * (1.f / 256.f) + LN_EPS);
            const size_t row = (size_t)(r0 + tb * 16 + c);
#pragma unroll
            for (int jb = 0; jb < 2; ++jb) { const int j = w * 32 + jb * 16 + q * 4;
                const u32x2 ru = *(const u32x2*)(PROJ + row * GLANP + 2048 + h * 256 + j);
                const f32x4 ng = jb ? ng1 : ng0;
                const float v0 = o[jb][tb][0] * rs * ng[0] * siluf(bflo(ru[0])), v1 = o[jb][tb][1] * rs * ng[1] * siluf(bfhi(ru[0]));
                const float v2 = o[jb][tb][2] * rs * ng[2] * siluf(bflo(ru[1])), v3 = o[jb][tb][3] * rs * ng[3] * siluf(bfhi(ru[1]));
                u32x2 u; u[0] = cvt_pk_bf16(v0, v1); u[1] = cvt_pk_bf16(v2, v3);
                *(u32x2*)(O + row * D + h * 256 + j) = u; } }
        __syncthreads();
    }
}

__device__ __forceinline__ void gla_sample_item(const Params& p, unsigned char* shm, int item) {
    const int tid = tidx(), lane = tid & 63, w = tid >> 6;
    const int b = item >> 2, h = item & 3;
    const bf16_t* PROJ = (const bf16_t*)(p.ws + WS_BIG);
    bf16_t* O = (bf16_t*)(p.ws + WS_H);
    float* A_ = (float*)shm; float* Q_ = A_ + 512; float* K_ = Q_ + 512; float* V_ = K_ + 512; float* OP = V_ + 1024; float* RED = OP + 2048;
    { const int i = tid & 127, t = tid >> 7; const size_t row = (size_t)(LP + b * 4 + t);
      float z = p.in[16][h * 128 + i];
#pragma unroll
      for (int j = 0; j < 16; ++j) z += bf2f(PROJ[row * GLANP + 3072 + j]) * p.in[15][j * 512 + h * 128 + i];
      A_[t * 128 + i] = __expf(log_sigmoid(z) * (1.f / 16.f));
      Q_[t * 128 + i] = bf2f(PROJ[row * GLANP + h * 128 + i]) * 0.08838834764831845f;
      K_[t * 128 + i] = bf2f(PROJ[row * GLANP + 512 + h * 128 + i]); }
#pragma unroll
    for (int e = 0; e < 2; ++e) { const int idx = tid + e * 512, t = idx >> 8, j = idx & 255; V_[idx] = bf2f(PROJ[(size_t)(LP + b * 4 + t) * GLANP + 1024 + h * 256 + j]); }
    __syncthreads();
    const int j = tid & 255, half = tid >> 8;
    const float v0 = V_[j], v1 = V_[256 + j], v2 = V_[512 + j], v3 = V_[768 + j];
    float o0 = 0.f, o1 = 0.f, o2 = 0.f, o3 = 0.f;
    const float* sin_ = p.in[4] + (size_t)(b * 4 + h) * 128 * 256; float* sout = p.out + O_GS + (size_t)(b * 4 + h) * 128 * 256;
#pragma unroll 8
    for (int ii = 0; ii < 64; ++ii) { const int i = half * 64 + ii;
        float S = sin_[i * 256 + j];
        S = A_[i] * S + K_[i] * v0; o0 += Q_[i] * S;
        S = A_[128 + i] * S + K_[128 + i] * v1; o1 += Q_[128 + i] * S;
        S = A_[256 + i] * S + K_[256 + i] * v2; o2 += Q_[256 + i] * S;
        S = A_[384 + i] * S + K_[384 + i] * v3; o3 += Q_[384 + i] * S;
        sout[i * 256 + j] = S; }
    OP[(half * 4 + 0) * 256 + j] = o0; OP[(half * 4 + 1) * 256 + j] = o1; OP[(half * 4 + 2) * 256 + j] = o2; OP[(half * 4 + 3) * 256 + j] = o3;
    __syncthreads();
    const int t0 = half * 2;
    const float a0 = OP[t0 * 256 + j] + OP[(4 + t0) * 256 + j], a1 = OP[(t0 + 1) * 256 + j] + OP[(4 + t0 + 1) * 256 + j];
    const float s0 = wave_sum(a0 * a0), s1 = wave_sum(a1 * a1);
    if (lane == 0) { RED[w * 2] = s0; RED[w * 2 + 1] = s1; }
    __syncthreads();
    const int wb = half * 4;
    const float q0 = RED[wb * 2] + RED[(wb + 1) * 2] + RED[(wb + 2) * 2] + RED[(wb + 3) * 2];
    const float q1 = RED[wb * 2 + 1] + RED[(wb + 1) * 2 + 1] + RED[(wb + 2) * 2 + 1] + RED[(wb + 3) * 2 + 1];
    const float ng = p.in[17][j];
    { const size_t row = (size_t)(LP + b * 4 + t0);
      const float r0v = bf2f(PROJ[row * GLANP + 2048 + h * 256 + j]), r1v = bf2f(PROJ[(row + 1) * GLANP + 2048 + h * 256 + j]);
      O[row * D + h * 256 + j] = (bf16_t)(cvt_pk_bf16(a0 * rsqrtf(q0 * (1.f / 256.f) + LN_EPS) * ng * siluf(r0v), 0.f) & 0xffffu);
      O[(row + 1) * D + h * 256 + j] = (bf16_t)(cvt_pk_bf16(a1 * rsqrtf(q1 * (1.f / 256.f) + LN_EPS) * ng * siluf(r1v), 0.f) & 0xffffu); }
    __syncthreads();
}

#define XB_TMO      128
#define XB_XCNT(j)  (256  + 64 * (j))
#define XB_XSUB(j)  (1280 + 64 * (j))
#define XB_XGEN(j)  (2304 + 64 * (j))
#define XB_TOP      3328
#define XB_TOPGEN   3392
#define XCD_BAR_WORDS 3456
#define XB_SPIN_CAP (1u << 18)

__device__ __forceinline__ unsigned xb_ld(unsigned* p)              { return __hip_atomic_load(p, __ATOMIC_RELAXED, __HIP_MEMORY_SCOPE_AGENT); }
__device__ __forceinline__ unsigned xb_add(unsigned* p, unsigned v) { return __hip_atomic_fetch_add(p, v, __ATOMIC_RELAXED, __HIP_MEMORY_SCOPE_AGENT); }
__device__ __forceinline__ unsigned xb_xcc_id() { return (unsigned)__builtin_amdgcn_s_getreg((3 << 11) | 20) & 0xFu; }
#define XB_SPIN(cond, bar) do { unsigned _sp = 0; while (cond) { __builtin_amdgcn_s_sleep(1); \
    if ((++_sp & 255u) == 0u) { if (xb_ld(&(bar)[XB_TMO])) break; if (_sp > XB_SPIN_CAP) { atomicAdd(&(bar)[XB_TMO], 1u); break; } } } } while (0)

struct XcdBarrier {
    unsigned* bar; unsigned x;
    volatile LAS unsigned* st;
};

__device__ __forceinline__ XcdBarrier xcd_barrier_post(unsigned* bar, volatile LAS unsigned* st) {
    XcdBarrier b; b.bar = bar; b.x = xb_xcc_id(); b.st = st;
    if (threadIdx.x == 0) (void)xb_add(&bar[XB_XCNT(b.x)], 1u);
    return b;
}
__device__ __forceinline__ void xcd_barrier_complete(unsigned* bar, unsigned x, unsigned& nloc, unsigned& nx) {
    const unsigned G = gridDim.x * gridDim.y * gridDim.z;
    unsigned sum, cnt, mine, sp = 0u;
    for (;;) {
        sum = 0u; cnt = 0u; mine = 0u;
#pragma unroll
        for (unsigned j = 0; j < 16; ++j) { const unsigned c = xb_ld(&bar[XB_XCNT(j)]); sum += c; cnt += (c > 0u) ? 1u : 0u; mine = (j == x) ? c : mine; }
        if (sum == G) break;
        __builtin_amdgcn_s_sleep(1);
        if ((++sp & 255u) == 0u) { if (xb_ld(&bar[XB_TMO])) break; if (sp > XB_SPIN_CAP) { atomicAdd(&bar[XB_TMO], 1u); break; } }
    }
    nloc = mine > 0u ? mine : 1u; nx = cnt > 0u ? cnt : 1u;
}

__device__ __forceinline__ void xcd_barrier(const XcdBarrier& b) {
    asm volatile("s_waitcnt vmcnt(0)" ::: "memory");
    __syncthreads();
    if (threadIdx.x == 0) {
        unsigned* bar = b.bar;
        __builtin_amdgcn_s_waitcnt(0);
        unsigned nloc = b.st[0], nx = b.st[1];
        if (nloc == 0u) { xcd_barrier_complete(bar, b.x, nloc, nx); b.st[0] = nloc; b.st[1] = nx; }
        const unsigned old = xb_add(&bar[XB_XSUB(b.x)], 1u);
        const unsigned gen = old / nloc;
        if (old + 1u == (gen + 1u) * nloc) {
            __builtin_amdgcn_fence(__ATOMIC_RELEASE, "agent");
            asm volatile("s_waitcnt vmcnt(0)" ::: "memory");
            const unsigned og = xb_add(&bar[XB_TOP], 1u);
            const unsigned tg = og / nx;
            if (og + 1u == (tg + 1u) * nx) xb_add(&bar[XB_TOPGEN], 1u);
            else XB_SPIN(xb_ld(&bar[XB_TOPGEN]) == tg, bar);
            __builtin_amdgcn_fence(__ATOMIC_ACQUIRE, "agent");
            xb_add(&bar[XB_XGEN(b.x)], 1u);
            asm volatile("s_waitcnt vmcnt(0)" ::: "memory");
        } else {
            XB_SPIN(xb_ld(&bar[XB_XGEN(b.x)]) == gen, bar);
            __builtin_amdgcn_fence(__ATOMIC_ACQUIRE, "agent");
            asm volatile("s_waitcnt vmcnt(0)" ::: "memory");
        }
    }
    __syncthreads();
}

#ifndef USE_XB
#define USE_XB 1
#endif
#ifndef REP_MASK
#define REP_MASK 0u
#endif
#ifndef EXTRA_SYNCS
#define EXTRA_SYNCS 0
#endif
#ifndef PROBE_LN
#define PROBE_LN 0
#endif
#ifndef PROBE_GS
#define PROBE_GS 0
#endif
#ifndef PROBE_W2
#define PROBE_W2 0
#endif
#ifndef ONLY_PH
#define ONLY_PH -1
#endif
#define PHSEL(n) (ONLY_PH < 0 || ONLY_PH == (n))
__global__ void __launch_bounds__(512, 2) mega(Params p) {
    extern __shared__ __attribute__((aligned(16))) unsigned char shm[];
    cg::grid_group grid = cg::this_grid();
    const int wg = blockIdx.x, nwg = gridDim.x;
    unsigned char* ws = p.ws;
    const float* MOD = (const float*)(ws + WS_MOD);
    bf16_t* Hb = (bf16_t*)(ws + WS_H);
    bf16_t* BIG = (bf16_t*)(ws + WS_BIG);
    LAS unsigned char* lds = (LAS unsigned char*)shm;
    volatile LAS unsigned* xst = (volatile LAS unsigned*)(lds + 131072);
    if (threadIdx.x == 0) { xst[0] = 0u; xst[1] = 0u; }
    __syncthreads();
    const XcdBarrier xb = xcd_barrier_post((unsigned*)(ws + WS_CTL), xst);
#define GSYNC() do { if (USE_XB) xcd_barrier(xb); else grid.sync(); } while (0)
#define PH(n) if (PHSEL(n))
    if (p.ph_lo == 0x7fffffff) grid.sync();
    PH(0) phase_prep(p, shm, wg, nwg, 0);
    GSYNC();
    PH(1) { pg8::Gemm g{(const bf16_t*)(ws + WS_CMAT), BIG, CPAD, MODN, D, D}; pg8::StaticOrder S; S.init(CPAD, MODN, nwg, wg);
            pg8::EpiF32 E{(float*)(ws + WS_MOD), MODN, p.in[8]}; pg8::gemm_phase(lds, g, S, E); }
    PH(0) if (wg >= 48) phase_prep(p, shm, wg - 48, nwg - 48, 1);
    GSYNC();
    PH(2) phase_mod0(p, wg, nwg);
    GSYNC();
#pragma unroll 1
    for (int l = 0; l < 2; ++l) {
        PH(3) { const int N = l ? GLANP : NQKV;
                pg8::Gemm g{Hb, (const bf16_t*)(ws + (l ? WS_WT_GIN : WS_WT_AIN)), R, N, D, D}; pg8::StaticOrder S; S.init(R, N, nwg, wg);
                pg8::EpiBf16 E{BIG, N, 0}; pg8::gemm_phase(lds, g, S, E); }
        PH(0) if (l == 0 && wg >= 140) phase_prep(p, shm, wg - 140, nwg - 140, 2);
        GSYNC();
        if (l == 0) {
            PH(4) for (int u = wg; u < 512 + 512; u += nwg) { if (u < 512) attn_prompt_unit(p, shm, u); else attn_sample_unit(p, shm, u - 512); }
            GSYNC();
        } else {
            PH(11) for (int u = wg; u < 256; u += nwg) gla_g1_item(p, shm, u);
            GSYNC();
            PH(12) { gla_g2(p, wg, nwg); for (int u = wg; u < 512; u += nwg) gla_sample_item(p, shm, u); }
            GSYNC();
            PH(13) for (int u = wg; u < 256; u += nwg) gla_g3_item(p, shm, u);
            GSYNC();
        }
        PH(5) { pg8::Gemm g{Hb, (const bf16_t*)(ws + (l ? WS_WT_GOUT : WS_WT_AOUT)), R, D, D, 256}; pg8::SplitOrder S; S.init(D, 4, nwg, wg);
                pg8::EpiResid E{p.out, l ? p.out : p.in[0], l ? p.out + (size_t)LP * D : p.in[1], MOD + (2 * l) * 3072 + 2048, (float*)(ws + WS_PART), nullptr,
                                l ? p.in[9] + 1 * D : nullptr, l ? p.in[10] + 1 * D : nullptr, (const float*)(ws + WS_STATS)}; pg8::gemm_phase(lds, g, S, E); }
        GSYNC();
        PH(6) phase_ln(p, 2 * l, 2 * l + 1, 4, 2 * l, wg, nwg);
        GSYNC();
        PH(7) { pg8::Gemm g{Hb, (const bf16_t*)(ws + WS_WT_W1) + (size_t)l * DFF * D, R, DFF, D, D}; pg8::StaticOrder S; S.init(R, DFF, nwg, wg);
                pg8::EpiBf16 E{BIG, DFF, 1}; pg8::gemm_phase(lds, g, S, E); }
        GSYNC();
        PH(8) { pg8::Gemm g{BIG, (const bf16_t*)(ws + WS_WT_W2) + (size_t)l * D * DFF, R, D, DFF, 256}; pg8::SplitOrder S; S.init(D, 16, nwg, wg);
                pg8::EpiResid E{p.out, p.out, p.out + (size_t)LP * D, MOD + (l * 2 + 1) * 3072 + 2048, (float*)(ws + WS_PART), nullptr, p.in[9] + (l * 2) * D, p.in[10] + (l * 2) * D, (const float*)(ws + WS_STATS)}; pg8::gemm_phase(lds, g, S, E); }
        GSYNC();
        PH(9) phase_ln(p, 2 * l + 1, l ? -1 : 2, 16, 2 * l + 1, wg, nwg);
        if (l == 0) GSYNC();
    }
}

#ifndef MK_ONE_LAUNCH
#define MK_ONE_LAUNCH 1
#endif

extern "C" void kernel_launch(void* const* d_in, const int* in_sizes, int n_in, void* d_out, int out_size, void* d_ws, size_t ws_size, hipStream_t stream) {
    static int grid = 0;
    if (grid == 0) {
        if (n_in != 21 || ws_size < WS_END) { fprintf(stderr, "kernel_launch: unexpected n_in %d or ws_size %zu (< %zu)\n", n_in, ws_size, (size_t)WS_END); grid = -1; return; }
        int dev = 0, cus = 0, per_cu = 0;
        hipGetDevice(&dev);
        hipDeviceGetAttribute(&cus, hipDeviceAttributeMultiprocessorCount, dev);
        if (hipFuncSetAttribute((const void*)mega, hipFuncAttributeMaxDynamicSharedMemorySize, LDS_BYTES) != hipSuccess) { fprintf(stderr, "kernel_launch: hipFuncSetAttribute failed\n"); grid = -1; return; }
        if (hipOccupancyMaxActiveBlocksPerMultiprocessor(&per_cu, (const void*)mega, 512, LDS_BYTES) != hipSuccess || per_cu < 1) { fprintf(stderr, "kernel_launch: occupancy query failed (%d)\n", per_cu); per_cu = 1; }
        (void)hipGetLastError();
        grid = cus * per_cu;
    }
    if (grid < 0) return;
    if (hipMemsetAsync((char*)d_ws + WS_CTL, 0, CTL_BYTES, stream) != hipSuccess) { fprintf(stderr, "kernel_launch: memset failed\n"); return; }
    Params p{};
    for (int i = 0; i < 21; ++i) p.in[i] = (const float*)d_in[i];
    p.out = (float*)d_out; p.ws = (unsigned char*)d_ws;
#if MK_ONE_LAUNCH
    p.ph_lo = 0; p.ph_hi = NPH;
    void* args[] = {&p};
    hipError_t e = hipLaunchCooperativeKernel((const void*)mega, dim3(grid), dim3(512), args, LDS_BYTES, stream);
    if (e != hipSuccess) fprintf(stderr, "cooperative launch failed: %s (grid %d)\n", hipGetErrorString(e), grid);
#else
    for (int ph = 0; ph < NPH; ++ph) {
        p.ph_lo = ph; p.ph_hi = ph + 1;
        hipLaunchKernelGGL(mega, dim3(grid), dim3(512), LDS_BYTES, stream, p);
    }
#endif
}
```

```cpp
#include <hip/hip_runtime.h>
#include <hip/hip_cooperative_groups.h>
#include <cstdio>
#include <cstdint>
namespace cg = cooperative_groups;

#define LAS __attribute__((address_space(3)))
typedef unsigned short bf16_t;
typedef short bf16x8 __attribute__((ext_vector_type(8)));
typedef float f32x4 __attribute__((ext_vector_type(4)));
typedef unsigned u32x4 __attribute__((ext_vector_type(4)));
typedef unsigned u32x2 __attribute__((ext_vector_type(2)));

constexpr int D = 1024, LP = 16384, NSEQ = 128, LS = 4, RS = NSEQ * LS, R = LP + RS;
constexpr int CPAD = 256, MODN = 12288;
constexpr int NQKV = 1536, GLAN = 3088, GLANP = 3328, DFF = 4096;
constexpr float ALPHA = 1.4142135623730951f;
constexpr float LN_EPS = 1e-5f;
constexpr int NPH = 19;
constexpr int LDS_BYTES = 131072 + 1024;

constexpr size_t O_Y = 0, O_KP = 17301504, O_VP = 17334272, O_GP = 17367040, O_KS = 17498112, O_VS = 21692416, O_GS = 25886720;
constexpr size_t WS_WT_AIN = 0;
constexpr size_t WS_WT_AOUT = WS_WT_AIN + (size_t)NQKV * D * 2;
constexpr size_t WS_WT_GIN = WS_WT_AOUT + (size_t)D * D * 2;
constexpr size_t WS_WT_GOUT = WS_WT_GIN + (size_t)GLANP * D * 2;
constexpr size_t WS_WT_W1 = WS_WT_GOUT + (size_t)D * D * 2;
constexpr size_t WS_WT_W2 = WS_WT_W1 + (size_t)2 * DFF * D * 2;
constexpr size_t WS_MOD = WS_WT_W2 + (size_t)2 * DFF * D * 2;
constexpr size_t WS_CMAT = WS_MOD + (size_t)CPAD * MODN * 4;
constexpr size_t WS_H = WS_CMAT + (size_t)CPAD * D * 2;
constexpr size_t WS_GST = WS_H + (size_t)R * D * 2;
constexpr size_t WS_PART = WS_GST;
constexpr size_t WS_GDEC = WS_GST + (size_t)64 * 4 * 256 * 128 * 4;
constexpr size_t WS_BIG = WS_GDEC + (size_t)64 * 4 * 128 * 4;
constexpr size_t WS_CTL = WS_BIG + (size_t)R * DFF * 2;
constexpr size_t CTL_BYTES = 16384;
constexpr size_t WS_STATS = WS_CTL + CTL_BYTES;
constexpr size_t WS_END = WS_STATS + (size_t)R * 8;

struct Params {
    const float* in[21];
    float* out;
    unsigned char* ws;
    int ph_lo, ph_hi;
};

typedef __bf16 bf16x2_t __attribute__((ext_vector_type(2)));
typedef float f32x2_t __attribute__((ext_vector_type(2)));
__device__ __forceinline__ unsigned cvt_pk_bf16(float lo, float hi) { const f32x2_t v = {lo, hi}; const bf16x2_t r = __builtin_convertvector(v, bf16x2_t); return __builtin_bit_cast(unsigned, r); }
__device__ __forceinline__ float bf2f(bf16_t b) { return __builtin_bit_cast(float, (unsigned)b << 16); }
__device__ __forceinline__ float bflo(unsigned u) { return __builtin_bit_cast(float, u << 16); }
__device__ __forceinline__ float bfhi(unsigned u) { return __builtin_bit_cast(float, u & 0xffff0000u); }
__device__ __forceinline__ int tidx() { int t = threadIdx.x; asm volatile("" : "+v"(t)); return t; }
typedef short s16x4 __attribute__((ext_vector_type(4)));
__device__ __forceinline__ bf16x8 tr_pair(const bf16_t* p0, const bf16_t* p1) {
    const s16x4 a = __builtin_amdgcn_ds_read_tr16_b64_v4i16((LAS s16x4*)p0), b = __builtin_amdgcn_ds_read_tr16_b64_v4i16((LAS s16x4*)p1);
    return (bf16x8){a[0], a[1], a[2], a[3], b[0], b[1], b[2], b[3]};
}
__device__ __forceinline__ float siluf(float x) { return x / (1.f + __expf(-x)); }
__device__ __forceinline__ float wave_sum(float v) {
#pragma unroll
    for (int o = 32; o > 0; o >>= 1) v += __shfl_xor(v, o, 64);
    return v;
}
__device__ __forceinline__ float wave_max(float v) {
#pragma unroll
    for (int o = 32; o > 0; o >>= 1) v = fmaxf(v, __shfl_xor(v, o, 64));
    return v;
}

namespace pg8 {
constexpr int BM = 256, BK = 64, HALF = 128, HTB = HALF * BK * 2, STAGE_BYTES = 8 * HTB, NXCD = 8, WGM = 8;
__host__ __device__ __forceinline__ int lds_byte(int r, int c) { const int st = (r >> 4) * 2 + (c >> 5), rr = r & 15, cc = c & 31, ob = rr * 64 + cc * 2; return st * 1024 + (ob ^ (((ob >> 9) & 1) << 5)); }
__host__ __device__ __forceinline__ void stage_rc(int b, int& Rr, int& C) { const int st = b / 1024, sb = b % 1024, swz = sb ^ (((sb >> 9) & 1) << 5); Rr = (st >> 1) * 16 + swz / 64; C = (st & 1) * 32 + (swz % 64) / 2; }
__host__ __device__ __forceinline__ int perm32(int rho) { const int n = rho >> 4, i = rho & 15; return 8 * (i >> 2) + 4 * n + (i & 3); }
struct Unit { int pm, pn, ks; };
struct Gemm { const bf16_t* A; const bf16_t* Bt; int M, N, K, Ksp; };
struct StaticOrder {
    int nM, nN, nwg, G, c;
    __host__ __device__ void init(int M, int N, int G_, int c_) { nM = M / BM; nN = N / BM; nwg = nM * nN; G = G_; c = c_; }
    __host__ __device__ bool next(int i, Unit& u) const {
        const long L = (long)i * G + c; if (L >= nwg) return false;
        int wgid = (int)L; { const int q = nwg / NXCD, r = nwg % NXCD, xcd = wgid % NXCD, off = wgid / NXCD; wgid = (xcd < r ? xcd * (q + 1) : r * (q + 1) + (xcd - r) * q) + off; }
        const int nig = WGM * nN, gid = wgid / nig, fm = gid * WGM, gsz = (nM - fm) < WGM ? (nM - fm) : WGM;
        u.pm = fm + ((wgid % nig) % gsz); u.pn = (wgid % nig) / gsz; u.ks = -1; return true;
    }
    __host__ __device__ int nextp(int i) const { Unit u; return next(i, u) ? (u.pm | (u.pn << 8)) : -1; }
    __device__ __forceinline__ void a_ready(const Unit&) const {}
    __device__ __forceinline__ void done(const Unit&) const {}
};
struct SplitOrder {
    StaticOrder P; int nN, nsplit, nsu;
    __host__ __device__ void init(int N, int nsplit_, int G_, int c_) { P.init(LP, N, G_, c_); nN = N / BM; nsplit = nsplit_; nsu = 2 * nN * nsplit; }
    __host__ __device__ bool next(int i, Unit& u) const {
        const long L = (long)i * P.G + P.c;
        if (L < P.nwg) return P.next(i, u);
        const int j = (int)(L - P.nwg); if (j >= nsu) return false;
        const int tile = j / nsplit; u.ks = j - tile * nsplit; u.pm = LP / BM + (tile & 1); u.pn = tile >> 1; return true;
    }
    __host__ __device__ int nextp(int i) const {
        const long L = (long)i * P.G + P.c;
        if (L < P.nwg) return P.nextp(i);
        const int j = (int)(L - P.nwg); if (j >= nsu) return -1;
        const int tile = j / nsplit;
        return (LP / BM + (tile & 1)) | ((tile >> 1) << 8) | ((j - tile * nsplit + 1) << 16);
    }
    __device__ __forceinline__ void a_ready(const Unit&) const {}
    __device__ __forceinline__ void done(const Unit&) const {}
};

struct EpiF32 {
    static constexpr bool PERM = false;
    float* C; int ldc; const float* bias;
    __device__ __forceinline__ void operator()(const f32x4 (&acc)[2][2][4][2], const Unit& u, int wr, int wc, int fr, int fq) const {
        const int row0 = u.pm * BM + wr * 64 + fr, col0 = u.pn * BM + wc * 32 + 4 * fq;
        f32x4 bv[2][2];
#pragma unroll
        for (int bj = 0; bj < 2; ++bj)
#pragma unroll
            for (int n = 0; n < 2; ++n) bv[bj][n] = *(const f32x4*)(bias + col0 + bj * HALF + n * 16);
#pragma unroll
        for (int ai = 0; ai < 2; ++ai)
#pragma unroll
            for (int m = 0; m < 4; ++m) { float* rowp = C + (size_t)(row0 + ai * HALF + m * 16) * ldc + col0;
#pragma unroll
                for (int bj = 0; bj < 2; ++bj)
#pragma unroll
                    for (int n = 0; n < 2; ++n) *(f32x4*)(rowp + bj * HALF + n * 16) = acc[ai][bj][m][n] + bv[bj][n]; }
    }
};
struct EpiBf16 {
    static constexpr bool PERM = true;
    bf16_t* O; int ldc; int act;
    __device__ __forceinline__ void operator()(const f32x4 (&acc)[2][2][4][2], const Unit& u, int wr, int wc, int fr, int fq) const {
        const int row0 = u.pm * BM + wr * 64 + fr, col0 = u.pn * BM + wc * 32 + 8 * fq;
#pragma unroll
        for (int ai = 0; ai < 2; ++ai)
#pragma unroll
            for (int m = 0; m < 4; ++m) { bf16_t* rowp = O + (size_t)(row0 + ai * HALF + m * 16) * ldc + col0;
#pragma unroll
                for (int bj = 0; bj < 2; ++bj) { f32x4 v0 = acc[ai][bj][m][0], v1 = acc[ai][bj][m][1];
                    if (act) {
#pragma unroll
                        for (int e = 0; e < 4; ++e) { float a = fmaxf(v0[e], 0.f), b = fmaxf(v1[e], 0.f); v0[e] = a * a; v1[e] = b * b; } }
                    u32x4 o; o[0] = cvt_pk_bf16(v0[0], v0[1]); o[1] = cvt_pk_bf16(v0[2], v0[3]); o[2] = cvt_pk_bf16(v1[0], v1[1]); o[3] = cvt_pk_bf16(v1[2], v1[3]);
                    *(u32x4*)(rowp + bj * HALF) = o; } }
    }
};
struct EpiResid {
    static constexpr bool PERM = false;
    float* Y; const float* X0; const float* X1; const float* gate; float* part; float* dry; const float* lg; const float* lb; const float* stats;
    __device__ __forceinline__ void operator()(const f32x4 (&acc)[2][2][4][2], const Unit& u, int wr, int wc, int fr, int fq) const {
        const int row0 = u.pm * BM + wr * 64 + fr, col0 = u.pn * BM + wc * 32 + 4 * fq;
        if (u.ks >= 0) {
            float* pb = part + ((size_t)u.ks * RS + (row0 - LP)) * D + col0;
#pragma unroll
            for (int ai = 0; ai < 2; ++ai)
#pragma unroll
                for (int m = 0; m < 4; ++m)
#pragma unroll
                    for (int bj = 0; bj < 2; ++bj)
#pragma unroll
                        for (int n = 0; n < 2; ++n) *(f32x4*)(pb + (size_t)(ai * HALF + m * 16) * D + bj * HALF + n * 16) = acc[ai][bj][m][n];
            return;
        }
#pragma unroll
        for (int bj = 0; bj < 2; ++bj)
#pragma unroll
            for (int n = 0; n < 2; ++n) {
                const int col = col0 + bj * HALF + n * 16;
                const f32x4 g = *(const f32x4*)(gate + col);
                f32x4 lgv = (f32x4){1.f, 1.f, 1.f, 1.f}, lbv = (f32x4){0.f, 0.f, 0.f, 0.f};
                if (lg) { lgv = *(const f32x4*)(lg + col); lbv = *(const f32x4*)(lb + col); }
#pragma unroll
                for (int r8 = 0; r8 < 8; ++r8) {
                    const int row = row0 + (r8 >> 2) * HALF + (r8 & 3) * 16;
                    f32x4 x = *(const f32x4*)(X0 + (size_t)row * D + col);
                    if (lg) { const float2 st = *(const float2*)(stats + 2 * (size_t)row); x = (x - st.x) * st.y * lgv + lbv; }
                    float* yr = dry ? dry + (size_t)(row & 4095) * D : Y + (size_t)row * D;
                    *(f32x4*)(yr + col) = x * ALPHA + g * acc[r8 >> 2][bj][r8 & 3][n]; } }
    }
};

template <class Epi, class Sched>
__device__ __forceinline__ void gemm_phase(LAS unsigned char* lds, const Gemm g, const Sched& S, const Epi& E) {
    const int tid = tidx(), wid = __builtin_amdgcn_readfirstlane(tid >> 6), lane = tid & 63, wr = wid >> 2, wc = wid & 3, fr = lane & 15, fq = lane >> 4;
    const int K = g.K;
    unsigned voffA[2], voffB[2];
#pragma unroll
    for (int i = 0; i < 2; ++i) { int Rr, C; stage_rc(tid * 16 + i * 8192, Rr, C); const int Rb = Epi::PERM ? ((Rr & ~31) + perm32(Rr & 31)) : Rr;
        voffA[i] = (unsigned)(Rr * K + C) * 2u; voffB[i] = (unsigned)(Rb * K + C) * 2u; }
    const size_t kstep = (size_t)(BK * 2);
    const size_t hstep = (size_t)HALF * K * 2;
    const size_t tstep = 2 * hstep;
    const unsigned ldsw = (unsigned)wid * 1024u;
    const int aoff = lds_byte(wr * 64 + fr, fq * 8), boff = lds_byte(wc * 32 + fr, fq * 8);
#define PG8_SA(b, h) (((b) * 2 + (h)) * HTB)
#define PG8_SB(b, h) ((4 + (b) * 2 + (h)) * HTB)
#define PG8_STAGE(bufoff, gbase, voff) do { _Pragma("unroll") for (int _i = 0; _i < 2; ++_i) \
        __builtin_amdgcn_global_load_lds((const unsigned*)((const char*)(gbase) + (voff)[_i]), (LAS unsigned*)(lds + (bufoff) + ldsw + _i * 8192), 16, 0, 0); } while (0)
#define PG8_LDA(dst, b, h) do { _Pragma("unroll") for (int m = 0; m < 4; ++m) _Pragma("unroll") for (int k = 0; k < 2; ++k) dst[m][k] = *(const LAS bf16x8*)(lds + PG8_SA(b, h) + aoff + m * 2048 + k * 1024); } while (0)
#define PG8_LDB(dst, b, h) do { _Pragma("unroll") for (int n = 0; n < 2; ++n) _Pragma("unroll") for (int k = 0; k < 2; ++k) dst[n][k] = *(const LAS bf16x8*)(lds + PG8_SB(b, h) + boff + n * 2048 + k * 1024); } while (0)
#define PG8_MMA(ai, bj, At, Bt) do { __builtin_amdgcn_s_setprio(1); _Pragma("unroll") for (int m = 0; m < 4; ++m) _Pragma("unroll") for (int n = 0; n < 2; ++n) _Pragma("unroll") for (int k = 0; k < 2; ++k) \
        acc[ai][bj][m][n] = __builtin_amdgcn_mfma_f32_16x16x32_bf16(Bt[n][k], At[m][k], acc[ai][bj][m][n], 0, 0, 0); __builtin_amdgcn_s_setprio(0); } while (0)
#define PG8_WAIT_V(n) asm volatile("s_waitcnt vmcnt(" #n ")" ::: "memory")
#define PG8_WAIT_L(n) asm volatile("s_waitcnt lgkmcnt(" #n ")" ::: "memory")
#define PG8_BAR __builtin_amdgcn_s_barrier()
#define PG8_SCHED __builtin_amdgcn_sched_barrier(0)
    Unit cur, nxt; int ui = 0;
    { const int pk = S.nextp(0); if (pk < 0) return; cur.pm = pk & 255; cur.pn = (pk >> 8) & 255; cur.ks = (pk >> 16) - 1; }
    f32x4 acc[2][2][4][2];
#pragma unroll
    for (int a = 0; a < 2; ++a)
#pragma unroll
        for (int b = 0; b < 2; ++b)
#pragma unroll
            for (int m = 0; m < 4; ++m)
#pragma unroll
                for (int n = 0; n < 2; ++n) acc[a][b][m][n] = (f32x4){0.f, 0.f, 0.f, 0.f};
    bf16x8 At[4][2], B0[2][2], B1[2][2];
    const size_t ksb = (size_t)g.Ksp * 2;
    const char* cA = (const char*)g.A + (size_t)cur.pm * tstep + (cur.ks < 0 ? (size_t)0 : cur.ks * ksb); const char* cB = (const char*)g.Bt + (size_t)cur.pn * tstep + (cur.ks < 0 ? (size_t)0 : cur.ks * ksb);
    int nt = (cur.ks < 0 ? K : g.Ksp) / BK;
    S.a_ready(cur);
    PG8_STAGE(PG8_SB(0, 0), cB, voffB); PG8_STAGE(PG8_SA(0, 0), cA, voffA); PG8_STAGE(PG8_SB(0, 1), cB + hstep, voffB); PG8_STAGE(PG8_SA(0, 1), cA + hstep, voffA);
    if (wr == 1) PG8_BAR;
    PG8_WAIT_V(4); PG8_BAR;
    PG8_STAGE(PG8_SB(1, 0), cB + kstep, voffB); PG8_STAGE(PG8_SA(1, 0), cA + kstep, voffA); PG8_STAGE(PG8_SB(1, 1), cB + hstep + kstep, voffB);
    PG8_WAIT_V(6); PG8_BAR;
    for (;;) {
        const int npk = S.nextp(ui + 1); const bool has_next = npk >= 0; nxt.pm = npk & 255; nxt.pn = (npk >> 8) & 255; nxt.ks = (npk >> 16) - 1;
        const size_t nko = (has_next && nxt.ks >= 0) ? nxt.ks * ksb : (size_t)0;
        const char* nA = has_next ? (const char*)g.A + (size_t)nxt.pm * tstep + nko : cA; const char* nB = has_next ? (const char*)g.Bt + (size_t)nxt.pn * tstep + nko : cB;
        for (int t = 0; t < nt; t += 2) {
            const bool last = (t == nt - 2);
            const char* a1 = cA + (size_t)(t + 1) * kstep;
            const char* a2 = last ? nA : cA + (size_t)(t + 2) * kstep; const char* b2 = last ? nB : cB + (size_t)(t + 2) * kstep;
            const char* a3 = a2 + kstep; const char* b3 = b2 + kstep;
            if (last && has_next) S.a_ready(nxt);
            PG8_LDB(B0, 0, 0); PG8_SCHED; PG8_LDA(At, 0, 0); PG8_STAGE(PG8_SA(1, 1), a1 + hstep, voffA);
            PG8_WAIT_L(8); PG8_BAR; PG8_WAIT_L(0); PG8_MMA(0, 0, At, B0); PG8_BAR; PG8_SCHED;
            PG8_LDB(B1, 0, 1); PG8_STAGE(PG8_SB(0, 0), b2, voffB);
            PG8_BAR; PG8_WAIT_L(0); PG8_MMA(0, 1, At, B1); PG8_BAR;
            PG8_LDA(At, 0, 1); PG8_STAGE(PG8_SA(0, 0), a2, voffA);
            PG8_BAR; PG8_WAIT_L(0); PG8_MMA(1, 0, At, B0); PG8_BAR; PG8_SCHED;
            PG8_STAGE(PG8_SB(0, 1), b2 + hstep, voffB);
            PG8_WAIT_V(6); PG8_BAR; PG8_MMA(1, 1, At, B1); PG8_BAR;
            PG8_LDB(B0, 1, 0); PG8_SCHED; PG8_LDA(At, 1, 0); PG8_STAGE(PG8_SA(0, 1), a2 + hstep, voffA);
            PG8_WAIT_L(8); PG8_BAR; PG8_WAIT_L(0); PG8_MMA(0, 0, At, B0); PG8_BAR; PG8_SCHED;
            PG8_LDB(B1, 1, 1); PG8_STAGE(PG8_SB(1, 0), b3, voffB);
            PG8_BAR; PG8_WAIT_L(0); PG8_MMA(0, 1, At, B1); PG8_BAR;
            PG8_LDA(At, 1, 1); PG8_STAGE(PG8_SA(1, 0), a3, voffA);
            PG8_BAR; PG8_WAIT_L(0); PG8_MMA(1, 0, At, B0); PG8_BAR; PG8_SCHED;
            PG8_STAGE(PG8_SB(1, 1), b3 + hstep, voffB);
            PG8_WAIT_V(6); PG8_BAR; PG8_MMA(1, 1, At, B1); PG8_BAR;
        }
        E(acc, cur, wr, wc, fr, fq); S.done(cur);
        if (!has_next) break;
#pragma unroll
        for (int a = 0; a < 2; ++a)
#pragma unroll
            for (int b = 0; b < 2; ++b)
#pragma unroll
                for (int m = 0; m < 4; ++m)
#pragma unroll
                    for (int n = 0; n < 2; ++n) acc[a][b][m][n] = (f32x4){0.f, 0.f, 0.f, 0.f};
        cur = nxt; cA = nA; cB = nB; ++ui; nt = (cur.ks < 0 ? K : g.Ksp) / BK;
    }
    PG8_WAIT_V(0);
    if (wr == 0) PG8_BAR;
    PG8_BAR;
#undef PG8_SA
#undef PG8_SB
#undef PG8_STAGE
#undef PG8_LDA
#undef PG8_LDB
#undef PG8_MMA
#undef PG8_WAIT_V
#undef PG8_WAIT_L
#undef PG8_BAR
#undef PG8_SCHED
}
}

__device__ __forceinline__ void transpose_convert(const float* __restrict__ W, bf16_t* __restrict__ Wt, int K, int N, int Npad, float* tile, int wg, int nwg) {
    const int tid = tidx();
    const int tn_n = Npad / 256, tk_n = K / 64, ntl = tn_n * tk_n;
    for (int t = wg; t < ntl; t += nwg) {
        const int tn = t % tn_n, tk = t / tn_n;
        float v[32];
#pragma unroll
        for (int e = 0; e < 32; ++e) { const int idx = e * 512 + tid, r = idx >> 8, c = idx & 255; const int col = tn * 256 + c;
            v[e] = col < N ? W[(size_t)(tk * 64 + r) * N + col] : 0.f; }
#pragma unroll
        for (int e = 0; e < 32; ++e) { const int idx = e * 512 + tid, r = idx >> 8, c = idx & 255; tile[r * 257 + c] = v[e]; }
        __syncthreads();
#pragma unroll
        for (int e = 0; e < 4; ++e) { const int ch = e * 512 + tid, n = ch >> 3, kc = ch & 7;
            u32x4 o;
#pragma unroll
            for (int j = 0; j < 4; ++j) o[j] = cvt_pk_bf16(tile[(kc * 8 + 2 * j) * 257 + n], tile[(kc * 8 + 2 * j + 1) * 257 + n]);
            *(u32x4*)(Wt + (size_t)(tn * 256 + n) * K + tk * 64 + kc * 8) = o; }
        __syncthreads();
    }
}

__device__ __forceinline__ void phase_prep(const Params& p, unsigned char* shm, int wg, int nwg, int part) {
    float* tile = (float*)shm;
    unsigned char* ws = p.ws;
    if (part == 0) {
        for (int m = 0; m < 4; ++m)
            transpose_convert(p.in[7] + (size_t)m * D * 3072, (bf16_t*)(ws + WS_BIG) + (size_t)m * 3072 * D, D, 3072, 3072, tile, wg, nwg);
        transpose_convert(p.in[11], (bf16_t*)(ws + WS_WT_AIN), D, NQKV, NQKV, tile, wg, nwg);
        transpose_convert(p.in[12], (bf16_t*)(ws + WS_WT_AOUT), D, D, D, tile, wg, nwg);
        bf16_t* cm = (bf16_t*)(ws + WS_CMAT);
        for (int idx = wg * 512 + tidx(); idx < CPAD * D; idx += nwg * 512) {
            const int r = idx >> 10, c = idx & 1023;
            float v = 0.f;
            if (r == 0) v = siluf(p.in[5][c]); else if (r <= NSEQ) v = siluf(p.in[6][(size_t)(r - 1) * D + c]);
            cm[idx] = (bf16_t)(cvt_pk_bf16(v, 0.f) & 0xffffu);
        }
    } else if (part == 1) {
        for (int l = 0; l < 2; ++l) {
            transpose_convert(p.in[19] + (size_t)l * D * DFF, (bf16_t*)(ws + WS_WT_W1) + (size_t)l * DFF * D, D, DFF, DFF, tile, wg, nwg);
            transpose_convert(p.in[20] + (size_t)l * DFF * D, (bf16_t*)(ws + WS_WT_W2) + (size_t)l * D * DFF, DFF, D, D, tile, wg, nwg);
        }
    } else {
        transpose_convert(p.in[14], (bf16_t*)(ws + WS_WT_GIN), D, GLAN, GLANP, tile, wg, nwg);
        transpose_convert(p.in[18], (bf16_t*)(ws + WS_WT_GOUT), D, D, D, tile, wg, nwg);
    }
}

__device__ __forceinline__ int crow_of(int row) { return row < LP ? 0 : 1 + ((row - LP) >> 2); }

__device__ __forceinline__ void phase_mod0(const Params& p, int wg, int nwg) {
    const int tid = tidx(), lane = tid & 63, wave = tid >> 6;
    const float* mod = (const float*)(p.ws + WS_MOD);
    bf16_t* H = (bf16_t*)(p.ws + WS_H);
    f32x4 sh0[4], sc0[4];
#pragma unroll
    for (int k = 0; k < 4; ++k) { sh0[k] = *(const f32x4*)(mod + k * 256 + lane * 4); sc0[k] = *(const f32x4*)(mod + 1024 + k * 256 + lane * 4) + 1.f; }
#pragma unroll 2
    for (int row = wg * 8 + wave; row < R; row += nwg * 8) {
        const float* xr = row < LP ? p.in[0] + (size_t)row * D : p.in[1] + (size_t)(row - LP) * D;
        const float* mr = mod + (size_t)crow_of(row) * MODN;
#pragma unroll
        for (int k = 0; k < 4; ++k) { const int col = k * 256 + lane * 4;
            const f32x4 x = *(const f32x4*)(xr + col);
            f32x4 sh = sh0[k], sc = sc0[k];
            if (row >= LP) { sh = *(const f32x4*)(mr + col); sc = *(const f32x4*)(mr + 1024 + col) + 1.f; }
            const f32x4 h = x * sc + sh;
            u32x2 o; o[0] = cvt_pk_bf16(h[0], h[1]); o[1] = cvt_pk_bf16(h[2], h[3]);
            *(u32x2*)(H + (size_t)row * D + col) = o; }
    }
}

__device__ __forceinline__ void phase_ln(const Params& p, int lnidx, int nset, int nsplit, int gset, int wg, int nwg, bool dry = false) {
    const int tid = tidx(), lane = tid & 63, wave = tid >> 6;
    const float* mod = (const float*)(p.ws + WS_MOD);
    bf16_t* H = (bf16_t*)(p.ws + WS_H);
    float* stats = (float*)(p.ws + WS_STATS);
    float* Y = p.out;
    const float* g = p.in[9] + lnidx * D; const float* b = p.in[10] + lnidx * D;
    f32x4 gv[4], bv[4];
#pragma unroll
    for (int k = 0; k < 4; ++k) { gv[k] = *(const f32x4*)(g + k * 256 + lane * 4); bv[k] = *(const f32x4*)(b + k * 256 + lane * 4); }
    f32x4 gm[4], bm[4];
#pragma unroll
    for (int k = 0; k < 4; ++k) { gm[k] = gv[k]; bm[k] = bv[k];
        if (nset >= 0) { const f32x4 sh = *(const f32x4*)(mod + nset * 3072 + k * 256 + lane * 4), sc = *(const f32x4*)(mod + nset * 3072 + 1024 + k * 256 + lane * 4) + 1.f;
            gm[k] = gv[k] * sc; bm[k] = bv[k] * sc + sh; } }
    const int rstep = nwg * 8;
    f32x4 nv[4];
    { const int row0 = wg * 8 + wave;
#pragma unroll
      for (int k = 0; k < 4; ++k) nv[k] = *(const f32x4*)(Y + (size_t)row0 * D + k * 256 + lane * 4); }
    for (int row = wg * 8 + wave; row < R; row += rstep) {
        float* yr = Y + (size_t)row * D;
        f32x4 v[4]; float s = 0.f;
        if (row < LP) {
#pragma unroll
            for (int k = 0; k < 4; ++k) v[k] = nv[k];
            if (row + rstep < LP) {
#pragma unroll
                for (int k = 0; k < 4; ++k) nv[k] = *(const f32x4*)(yr + (size_t)rstep * D + k * 256 + lane * 4); }
        } else {
            const float* pr = (const float*)(p.ws + WS_PART) + (size_t)(row - LP) * D;
            const float* gr = mod + (size_t)crow_of(row) * MODN + gset * 3072 + 2048;
            float mu0 = 0.f, rs0 = 1.f;
            if (lnidx > 0) { const float2 st = *(const float2*)(stats + 2 * (size_t)row); mu0 = st.x; rs0 = st.y; }
#pragma unroll
            for (int k = 0; k < 4; ++k) { const int col = k * 256 + lane * 4;
                f32x4 a = *(const f32x4*)(pr + col);
#pragma unroll 3
                for (int sp = 1; sp < nsplit; ++sp) a = a + *(const f32x4*)(pr + (size_t)sp * RS * D + col);
                f32x4 x;
                if (lnidx == 0) x = *(const f32x4*)(p.in[1] + (size_t)(row - LP) * D + col);
                else x = (*(const f32x4*)(yr + col) - mu0) * rs0 * *(const f32x4*)(g - D + col) + *(const f32x4*)(b - D + col);
                v[k] = x * ALPHA + *(const f32x4*)(gr + col) * a;
                if (nset >= 0 && !dry) *(f32x4*)(yr + col) = v[k]; }
        }
#pragma unroll
        for (int k = 0; k < 4; ++k) s += v[k][0] + v[k][1] + v[k][2] + v[k][3];
        const float mu = wave_sum(s) * (1.f / D);
        float q = 0.f;
#pragma unroll
        for (int k = 0; k < 4; ++k) { const f32x4 d = v[k] - mu; q += d[0] * d[0] + d[1] * d[1] + d[2] * d[2] + d[3] * d[3]; }
        const float rstd = rsqrtf(wave_sum(q) * (1.f / D) + LN_EPS);
        if (nset >= 0 && lane == 0 && !dry) *(float2*)(stats + 2 * (size_t)row) = make_float2(mu, rstd);
        const float* mr = mod + (size_t)crow_of(row) * MODN + (nset >= 0 ? nset * 3072 : 0);
#pragma unroll
        for (int k = 0; k < 4; ++k) { const int col = k * 256 + lane * 4;
            const f32x4 x = (v[k] - mu) * rstd * gv[k] + bv[k];
            if (nset < 0) *(f32x4*)(yr + col) = x;
            else {
                f32x4 h;
                if (row < LP) h = (v[k] - mu) * rstd * gm[k] + bm[k];
                else { const f32x4 sh = *(const f32x4*)(mr + col), sc = *(const f32x4*)(mr + 1024 + col); h = x * (sc + 1.f) + sh; }
                u32x2 o; o[0] = cvt_pk_bf16(h[0], h[1]); o[1] = cvt_pk_bf16(h[2], h[3]);
                *(u32x2*)((dry ? (bf16_t*)(p.ws + WS_BIG + (size_t)80 * 1024 * 1024) : H) + (size_t)row * D + col) = o; } }
    }
}

__device__ __forceinline__ void attn_prompt_unit(const Params& p, unsigned char* shm, int unit) {
    const int tid = tidx(), lane = tid & 63, w = tid >> 6, c = lane & 15, q = lane >> 4;
    const int nb = unit >> 2, hk = unit & 3;
    const bf16_t* QKV = (const bf16_t*)(p.ws + WS_BIG);
    bf16_t* O = (bf16_t*)(p.ws + WS_H);
    bf16_t* Ks = (bf16_t*)shm;
    bf16_t* Vs = (bf16_t*)(shm + 36864);
    const int rbase = nb * 128 - 128;
#pragma unroll
    for (int i = 0; i < 4; ++i) { const int ch = tid + i * 512, s = ch >> 3, cc = ch & 7; const int grow = rbase + s;
        u32x4 v = (u32x4){0u, 0u, 0u, 0u};
        if (grow >= 0) v = *(const u32x4*)(QKV + (size_t)grow * NQKV + 1024 + hk * 64 + cc * 8);
        *(u32x4*)(Ks + s * 72 + cc * 8) = v; }
#pragma unroll
    for (int i = 0; i < 4; ++i) { const int ch = tid + i * 512, sr = ch >> 3, cc = ch & 7; const int grow = rbase + sr;
        u32x4 v = (u32x4){0u, 0u, 0u, 0u};
        if (grow >= 0) v = *(const u32x4*)(QKV + (size_t)grow * NQKV + 1280 + hk * 64 + cc * 8);
        *(u32x4*)(Vs + sr * 72 + cc * 8) = v; }
    if (nb == 127) {
        float* ok = p.out + O_KP; float* ov = p.out + O_VP;
        for (int idx = tid; idx < 128 * 64; idx += 512) { const int s = idx >> 6, d = idx & 63; const size_t row = (size_t)(LP - 128 + s);
            ok[(s * 4 + hk) * 64 + d] = bf2f(QKV[row * NQKV + 1024 + hk * 64 + d]);
            ov[(s * 4 + hk) * 64 + d] = bf2f(QKV[row * NQKV + 1280 + hk * 64 + d]); }
    }
    __syncthreads();
#pragma unroll 1
    for (int it = 0; it < 4; ++it) {
        const int task = w + 8 * (it >> 1), tt = it & 1;
        const int hq = hk * 4 + (task >> 2), w0 = (task & 3) * 32;
        const float slope = exp2f(-0.5f * (float)(hq + 1));
        const float sink = p.in[13][hq];
        bf16x8 qf[2];
#pragma unroll
        for (int kk = 0; kk < 2; ++kk) qf[kk] = *(const bf16x8*)(QKV + (size_t)(nb * 128 + w0 + tt * 16 + c) * NQKV + hq * 64 + kk * 32 + q * 8);
        f32x4 sc[10];
#pragma unroll
        for (int st = 0; st < 10; ++st) {
            sc[st] = (f32x4){0.f, 0.f, 0.f, 0.f};
#pragma unroll
            for (int kk = 0; kk < 2; ++kk) {
                const bf16x8 kf = *(const bf16x8*)(Ks + (w0 + st * 16 + c) * 72 + kk * 32 + q * 8);
                sc[st] = __builtin_amdgcn_mfma_f32_16x16x32_bf16(kf, qf[kk], sc[st], 0, 0, 0);
            }
        }
        float mx = sink;
        const int tq = w0 + tt * 16 + c;
#pragma unroll
        for (int st = 0; st < 10; ++st)
#pragma unroll
            for (int e = 0; e < 4; ++e) {
                const int s = w0 + st * 16 + q * 4 + e, dist = tq + 128 - s;
                const bool valid = dist >= 0 && dist <= 128 && (nb > 0 || s >= 128);
                const float v = valid ? sc[st][e] * 0.125f - slope * (float)dist : -INFINITY;
                sc[st][e] = v; mx = fmaxf(mx, v);
            }
        mx = fmaxf(mx, __shfl_xor(mx, 16, 64)); mx = fmaxf(mx, __shfl_xor(mx, 32, 64));
        float ssum = 0.f;
#pragma unroll
        for (int st = 0; st < 10; ++st)
#pragma unroll
            for (int e = 0; e < 4; ++e) { const float pv = __expf(sc[st][e] - mx); sc[st][e] = pv; ssum += pv; }
        ssum += __shfl_xor(ssum, 16, 64); ssum += __shfl_xor(ssum, 32, 64);
        const float linv = 1.f / (ssum + __expf(sink - mx));
        f32x4 o[4];
#pragma unroll
        for (int dt = 0; dt < 4; ++dt) o[dt] = (f32x4){0.f, 0.f, 0.f, 0.f};
#pragma unroll
        for (int pp = 0; pp < 5; ++pp) {
            u32x4 pu; pu[0] = cvt_pk_bf16(sc[2 * pp][0], sc[2 * pp][1]); pu[1] = cvt_pk_bf16(sc[2 * pp][2], sc[2 * pp][3]);
            pu[2] = cvt_pk_bf16(sc[2 * pp + 1][0], sc[2 * pp + 1][1]); pu[3] = cvt_pk_bf16(sc[2 * pp + 1][2], sc[2 * pp + 1][3]);
            const bf16x8 pf = __builtin_bit_cast(bf16x8, pu);
#pragma unroll
            for (int dt = 0; dt < 4; ++dt) {
                const bf16_t* vp = Vs + (w0 + 32 * pp + 4 * q + (c >> 2)) * 72 + dt * 16 + 4 * (c & 3);
                const bf16x8 vf = tr_pair(vp, vp + 16 * 72);
                o[dt] = __builtin_amdgcn_mfma_f32_16x16x32_bf16(vf, pf, o[dt], 0, 0, 0);
            }
        }
#pragma unroll
        for (int dt = 0; dt < 4; ++dt) {
            const f32x4 v = o[dt] * linv;
            u32x2 u; u[0] = cvt_pk_bf16(v[0], v[1]); u[1] = cvt_pk_bf16(v[2], v[3]);
            *(u32x2*)(O + (size_t)(nb * 128 + w0 + tt * 16 + c) * D + hq * 64 + dt * 16 + q * 4) = u;
        }
    }
    __syncthreads();
}

__device__ __forceinline__ void attn_sample_unit(const Params& p, unsigned char* shm, int unit) {
    const int tid = tidx(), lane = tid & 63, w = tid >> 6;
    const int b = unit >> 2, hk = unit & 3;
    const bf16_t* QKV = (const bf16_t*)(p.ws + WS_BIG);
    bf16_t* O = (bf16_t*)(p.ws + WS_H);
    float* Kf = (float*)shm;
    float* Vf = Kf + 132 * 65;
    float* Qf = Vf + 132 * 65;
    float* P = Qf + 16 * 64;
    const float* ck = p.in[2]; const float* cv = p.in[3];
    float* ok = p.out + O_KS; float* ov = p.out + O_VS;
    for (int idx = tid; idx < 128 * 64; idx += 512) { const int j = idx >> 6, d = idx & 63;
        const size_t src = ((size_t)(b * 128 + j) * 4 + hk) * 64 + d;
        const float kv = ck[src], vv = cv[src];
        Kf[j * 65 + d] = kv; Vf[j * 65 + d] = vv;
        if (j >= 4) { const size_t dst = ((size_t)(b * 128 + j - 4) * 4 + hk) * 64 + d; ok[dst] = kv; ov[dst] = vv; } }
    if (tid < 256) { const int t = tid >> 6, d = tid & 63; const size_t row = (size_t)(LP + b * 4 + t);
        const float kv = bf2f(QKV[row * NQKV + 1024 + hk * 64 + d]), vv = bf2f(QKV[row * NQKV + 1280 + hk * 64 + d]);
        Kf[(128 + t) * 65 + d] = kv; Vf[(128 + t) * 65 + d] = vv;
        const size_t dst = ((size_t)(b * 128 + 124 + t) * 4 + hk) * 64 + d; ok[dst] = kv; ov[dst] = vv; }
    for (int idx = tid; idx < 16 * 64; idx += 512) { const int row = idx >> 6, d = idx & 63, g = row >> 2, t = row & 3;
        Qf[idx] = bf2f(QKV[(size_t)(LP + b * 4 + t) * NQKV + (hk * 4 + g) * 64 + d]); }
    __syncthreads();
    for (int idx = tid; idx < 16 * 132; idx += 512) { const int row = idx / 132, j = idx - row * 132, g = row >> 2, t = row & 3;
        const int dist = t + 128 - j;
        float v = -INFINITY;
        if (dist >= 0 && dist <= 128) {
            float a = 0.f;
#pragma unroll 16
            for (int d = 0; d < 64; ++d) a += Qf[row * 64 + d] * Kf[j * 65 + d];
            v = a * 0.125f - exp2f(-0.5f * (float)(hk * 4 + g + 1)) * (float)dist; }
        P[row * 136 + j] = v; }
    __syncthreads();
#pragma unroll
    for (int rr = 0; rr < 2; ++rr) { const int row = w * 2 + rr, g = row >> 2;
        const float sink = p.in[13][hk * 4 + g];
        float v0 = P[row * 136 + lane], v1 = P[row * 136 + 64 + lane], v2 = lane < 4 ? P[row * 136 + 128 + lane] : -INFINITY;
        const float m = fmaxf(wave_max(fmaxf(fmaxf(v0, v1), v2)), sink);
        v0 = __expf(v0 - m); v1 = __expf(v1 - m); v2 = __expf(v2 - m);
        const float inv = 1.f / (wave_sum(v0 + v1 + v2) + __expf(sink - m));
        P[row * 136 + lane] = v0 * inv; P[row * 136 + 64 + lane] = v1 * inv; if (lane < 4) P[row * 136 + 128 + lane] = v2 * inv; }
    __syncthreads();
#pragma unroll
    for (int rr = 0; rr < 2; ++rr) { const int idx = tid + rr * 512, row = idx >> 6, d = idx & 63, g = row >> 2, t = row & 3;
        float a = 0.f;
        for (int j = 0; j < 132; ++j) a += P[row * 136 + j] * Vf[j * 65 + d];
        O[(size_t)(LP + b * 4 + t) * D + (hk * 4 + g) * 64 + d] = (bf16_t)(cvt_pk_bf16(a, 0.f) & 0xffffu); }
    __syncthreads();
}

constexpr int G_QD = 0;
constexpr int G_KD = 17408;
constexpr int G_KDT = 34816;
constexpr int G_VT = 53248;
constexpr int G_AM = 90112;
constexpr int G_GD = 99328;
constexpr int G_EBC = 103424;
constexpr int G_SEG = 103936;
constexpr int G_RED = 105984;

__device__ __forceinline__ float log_sigmoid(float z) { return fminf(z, 0.f) - __logf(1.f + __expf(-fabsf(z))); }

template <bool FULL>
__device__ __forceinline__ float gla_preamble(const bf16_t* PROJ, unsigned char* shm, int r0, int h, const float (&wup)[16], float bg) {
    const int tid = tidx();
    bf16_t* QD = (bf16_t*)(shm + G_QD); bf16_t* KD = (bf16_t*)(shm + G_KD); bf16_t* KDT = (bf16_t*)(shm + G_KDT); bf16_t* VT = (bf16_t*)(shm + G_VT);
    float* GD = (float*)(shm + G_GD); float* EBC = (float*)(shm + G_EBC); float* SEG = (float*)(shm + G_SEG);
#pragma unroll
    for (int e = 0; e < 2; ++e) { const int idx = tid + e * 512, t = idx >> 4, j = idx & 15; GD[idx] = bf2f(PROJ[(size_t)(r0 + t) * GLANP + 3072 + j]); }
    const int i = tid & 127, seg = tid >> 7;
    unsigned short kraw[16], qraw[16];
#pragma unroll
    for (int tt = 0; tt < 16; ++tt) { const size_t rr = (size_t)(r0 + seg * 16 + tt) * GLANP + h * 128 + i; kraw[tt] = PROJ[rr + 512]; if (FULL) qraw[tt] = PROJ[rr]; }
#pragma unroll
    for (int e = 0; e < 4; ++e) { const int ch = tid + e * 512, t = ch >> 5, cc = ch & 31;
        *(u32x4*)(VT + t * 264 + cc * 8) = *(const u32x4*)(PROJ + (size_t)(r0 + t) * GLANP + 1024 + h * 256 + cc * 8); }
    __syncthreads();
    float bl[16]; float run = 0.f;
#pragma unroll
    for (int tt = 0; tt < 16; ++tt) { const int t = seg * 16 + tt; float z = bg;
#pragma unroll
        for (int j = 0; j < 16; ++j) z += GD[t * 16 + j] * wup[j];
        run += log_sigmoid(z) * (1.f / 16.f); bl[tt] = run; }
    SEG[seg * 128 + i] = run;
    __syncthreads();
    float pre = 0.f, tot = 0.f;
#pragma unroll
    for (int s = 0; s < 4; ++s) { const float v = SEG[s * 128 + i]; tot += v; if (s < seg) pre += v; }
    float kdv[16];
#pragma unroll
    for (int tt = 0; tt < 16; ++tt) { const int t = seg * 16 + tt; const float bt = pre + bl[tt];
        const float kv = bf2f(kraw[tt]);
        kdv[tt] = kv * __expf(tot - bt);
        if (FULL) {
            const float qv = bf2f(qraw[tt]) * 0.08838834764831845f;
            QD[t * 136 + i] = (bf16_t)(cvt_pk_bf16(qv * __expf(bt), 0.f) & 0xffffu);
            KD[t * 136 + i] = (bf16_t)(cvt_pk_bf16(kv * __expf(-bt), 0.f) & 0xffffu);
        } }
    { u32x4 v0, v1;
      v0[0] = cvt_pk_bf16(kdv[0], kdv[1]); v0[1] = cvt_pk_bf16(kdv[2], kdv[3]); v0[2] = cvt_pk_bf16(kdv[4], kdv[5]); v0[3] = cvt_pk_bf16(kdv[6], kdv[7]);
      v1[0] = cvt_pk_bf16(kdv[8], kdv[9]); v1[1] = cvt_pk_bf16(kdv[10], kdv[11]); v1[2] = cvt_pk_bf16(kdv[12], kdv[13]); v1[3] = cvt_pk_bf16(kdv[14], kdv[15]);
      *(u32x4*)(KDT + i * 72 + seg * 16) = v0; *(u32x4*)(KDT + i * 72 + seg * 16 + 8) = v1; }
    if (seg == 0) EBC[i] = __expf(tot);
    __syncthreads();
    return tot;
}

__device__ __forceinline__ void gla_state_update(f32x4 (&S)[8][2], unsigned char* shm, int w, int c, int q) {
    const bf16_t* KDT = (const bf16_t*)(shm + G_KDT); const bf16_t* VT = (const bf16_t*)(shm + G_VT); const float* EBC = (const float*)(shm + G_EBC);
#pragma unroll
    for (int ib = 0; ib < 8; ++ib) { const f32x4 eb = *(const f32x4*)(EBC + ib * 16 + q * 4); S[ib][0] = S[ib][0] * eb; S[ib][1] = S[ib][1] * eb; }
#pragma unroll
    for (int kk = 0; kk < 2; ++kk) {
        bf16x8 vf[2];
#pragma unroll
        for (int jb = 0; jb < 2; ++jb) { const bf16_t* vp = VT + (kk * 32 + 8 * q + (c >> 2)) * 264 + w * 32 + jb * 16 + 4 * (c & 3); vf[jb] = tr_pair(vp, vp + 4 * 264); }
#pragma unroll
        for (int ib = 0; ib < 8; ++ib) { const bf16x8 kf = *(const bf16x8*)(KDT + (ib * 16 + c) * 72 + kk * 32 + q * 8);
            S[ib][0] = __builtin_amdgcn_mfma_f32_16x16x32_bf16(kf, vf[0], S[ib][0], 0, 0, 0);
            S[ib][1] = __builtin_amdgcn_mfma_f32_16x16x32_bf16(kf, vf[1], S[ib][1], 0, 0, 0); }
    }
}

__device__ __forceinline__ void gla_g1_item(const Params& p, unsigned char* shm, int item) {
    const int tid = tidx(), lane = tid & 63, w = tid >> 6, c = lane & 15, q = lane >> 4;
    const int sc = item >> 2, h = item & 3;
    const bf16_t* PROJ = (const bf16_t*)(p.ws + WS_BIG);
    float* GST = (float*)(p.ws + WS_GST); float* GDEC = (float*)(p.ws + WS_GDEC);
    float wup[16]; const int i = tid & 127;
#pragma unroll
    for (int j = 0; j < 16; ++j) wup[j] = p.in[15][j * 512 + h * 128 + i];
    const float bg = p.in[16][h * 128 + i];
    f32x4 S[8][2];
#pragma unroll
    for (int ib = 0; ib < 8; ++ib) { S[ib][0] = (f32x4){0.f, 0.f, 0.f, 0.f}; S[ib][1] = (f32x4){0.f, 0.f, 0.f, 0.f}; }
    float dec = 0.f;
#pragma unroll 1
    for (int ch = 0; ch < 4; ++ch) {
        dec += gla_preamble<false>(PROJ, shm, sc * 256 + ch * 64, h, wup, bg);
        gla_state_update(S, shm, w, c, q);
        __syncthreads();
    }
    float* dst = GST + (size_t)(sc * 4 + h) * 256 * 128;
#pragma unroll
    for (int ib = 0; ib < 8; ++ib)
#pragma unroll
        for (int jb = 0; jb < 2; ++jb) *(f32x4*)(dst + (size_t)(w * 32 + jb * 16 + c) * 128 + ib * 16 + q * 4) = S[ib][jb];
    if (tid < 128) GDEC[(sc * 4 + h) * 128 + tid] = dec;
}

__device__ __forceinline__ void gla_g2(const Params& p, int wg, int nwg) {
    float* GST = (float*)(p.ws + WS_GST); const float* GDEC = (const float*)(p.ws + WS_GDEC);
    float* og = p.out + O_GP;
    for (int idx = wg * 512 + tidx(); idx < 4 * 256 * 128; idx += nwg * 512) {
        const int h = idx >> 15, j = (idx >> 7) & 255, i = idx & 127;
        float S = 0.f;
        for (int s0 = 0; s0 < 64; s0 += 8) {
            float d[8], a[8];
#pragma unroll
            for (int k = 0; k < 8; ++k) { d[k] = GST[((size_t)((s0 + k) * 4 + h) * 256 + j) * 128 + i]; a[k] = GDEC[((s0 + k) * 4 + h) * 128 + i]; }
#pragma unroll
            for (int k = 0; k < 8; ++k) { GST[((size_t)((s0 + k) * 4 + h) * 256 + j) * 128 + i] = S; S = __expf(a[k]) * S + d[k]; }
        }
        og[(h * 128 + i) * 256 + j] = S;
    }
}

__device__ __forceinline__ void gla_g3_item(const Params& p, unsigned char* shm, int item) {
    const int tid = tidx(), lane = tid & 63, w = tid >> 6, c = lane & 15, q = lane >> 4;
    const int sc = item >> 2, h = item & 3;
    const bf16_t* PROJ = (const bf16_t*)(p.ws + WS_BIG);
    bf16_t* O = (bf16_t*)(p.ws + WS_H);
    const float* GST = (const float*)(p.ws + WS_GST);
    const bf16_t* QD = (const bf16_t*)(shm + G_QD); const bf16_t* KD = (const bf16_t*)(shm + G_KD); const bf16_t* VT = (const bf16_t*)(shm + G_VT);
    bf16_t* AM = (bf16_t*)(shm + G_AM); float* RED = (float*)(shm + G_RED);
    float wup[16]; const int i = tid & 127;
#pragma unroll
    for (int j = 0; j < 16; ++j) wup[j] = p.in[15][j * 512 + h * 128 + i];
    const float bg = p.in[16][h * 128 + i];
    f32x4 S[8][2];
    { const float* src = GST + (size_t)(sc * 4 + h) * 256 * 128;
#pragma unroll
      for (int ib = 0; ib < 8; ++ib)
#pragma unroll
          for (int jb = 0; jb < 2; ++jb) S[ib][jb] = *(const f32x4*)(src + (size_t)(w * 32 + jb * 16 + c) * 128 + ib * 16 + q * 4); }
    const f32x4 ng0 = *(const f32x4*)(p.in[17] + w * 32 + q * 4), ng1 = *(const f32x4*)(p.in[17] + w * 32 + 16 + q * 4);
#pragma unroll 1
    for (int ch = 0; ch < 4; ++ch) {
        const int r0 = sc * 256 + ch * 64;
        gla_preamble<true>(PROJ, shm, r0, h, wup, bg);
        { const int tb = w >> 1;
#pragma unroll
          for (int x = 0; x < 2; ++x) { const int sb = (w & 1) * 2 + x;
              f32x4 a = (f32x4){0.f, 0.f, 0.f, 0.f};
              if (sb <= tb) {
#pragma unroll
                  for (int kk = 0; kk < 4; ++kk) { const bf16x8 af = *(const bf16x8*)(QD + (tb * 16 + c) * 136 + kk * 32 + q * 8), bfv = *(const bf16x8*)(KD + (sb * 16 + c) * 136 + kk * 32 + q * 8);
                      a = __builtin_amdgcn_mfma_f32_16x16x32_bf16(af, bfv, a, 0, 0, 0); } }
#pragma unroll
              for (int e = 0; e < 4; ++e) { const int t = tb * 16 + q * 4 + e, s = sb * 16 + c;
                  AM[t * 72 + s] = (bf16_t)(cvt_pk_bf16(s <= t ? a[e] : 0.f, 0.f) & 0xffffu); } } }
        __syncthreads();
        f32x4 o[2][4];
#pragma unroll
        for (int jb = 0; jb < 2; ++jb)
#pragma unroll
            for (int tb = 0; tb < 4; ++tb) o[jb][tb] = (f32x4){0.f, 0.f, 0.f, 0.f};
#pragma unroll
        for (int pp = 0; pp < 4; ++pp) {
            bf16x8 sf[2];
#pragma unroll
            for (int jb = 0; jb < 2; ++jb) { u32x4 u;
                u[0] = cvt_pk_bf16(S[2 * pp][jb][0], S[2 * pp][jb][1]); u[1] = cvt_pk_bf16(S[2 * pp][jb][2], S[2 * pp][jb][3]);
                u[2] = cvt_pk_bf16(S[2 * pp + 1][jb][0], S[2 * pp + 1][jb][1]); u[3] = cvt_pk_bf16(S[2 * pp + 1][jb][2], S[2 * pp + 1][jb][3]);
                sf[jb] = __builtin_bit_cast(bf16x8, u); }
#pragma unroll
            for (int tb = 0; tb < 4; ++tb) { const bf16_t* qp = QD + (tb * 16 + c) * 136 + 32 * pp + 4 * q;
                const u32x2 a = *(const u32x2*)qp, b = *(const u32x2*)(qp + 16); u32x4 u; u[0] = a[0]; u[1] = a[1]; u[2] = b[0]; u[3] = b[1];
                const bf16x8 qf = __builtin_bit_cast(bf16x8, u);
                o[0][tb] = __builtin_amdgcn_mfma_f32_16x16x32_bf16(sf[0], qf, o[0][tb], 0, 0, 0);
                o[1][tb] = __builtin_amdgcn_mfma_f32_16x16x32_bf16(sf[1], qf, o[1][tb], 0, 0, 0); }
        }
#pragma unroll
        for (int kk = 0; kk < 2; ++kk) {
            bf16x8 vf[2];
#pragma unroll
            for (int jb = 0; jb < 2; ++jb) { const bf16_t* vp = VT + (kk * 32 + 8 * q + (c >> 2)) * 264 + w * 32 + jb * 16 + 4 * (c & 3); vf[jb] = tr_pair(vp, vp + 4 * 264); }
#pragma unroll
            for (int tb = 0; tb < 4; ++tb) { const bf16x8 af = *(const bf16x8*)(AM + (tb * 16 + c) * 72 + kk * 32 + q * 8);
                o[0][tb] = __builtin_amdgcn_mfma_f32_16x16x32_bf16(vf[0], af, o[0][tb], 0, 0, 0);
                o[1][tb] = __builtin_amdgcn_mfma_f32_16x16x32_bf16(vf[1], af, o[1][tb], 0, 0, 0); }
        }
        gla_state_update(S, shm, w, c, q);
#pragma unroll
        for (int tb = 0; tb < 4; ++tb) { float s = 0.f;
#pragma unroll
            for (int jb = 0; jb < 2; ++jb)
#pragma unroll
                for (int e = 0; e < 4; ++e) s += o[jb][tb][e] * o[jb][tb][e];
            s += __shfl_xor(s, 16, 64); s += __shfl_xor(s, 32, 64);
            if (q == 0) RED[w * 64 + tb * 16 + c] = s; }
        __syncthreads();
#pragma unroll
        for (int tb = 0; tb < 4; ++tb) { float s = 0.f;
#pragma unroll
            for (int ww = 0; ww < 8; ++ww) s += RED[ww * 64 + tb * 16 + c];
            const float rs = rsqrtf(s * (1.f / 256.f) + LN_EPS);
            const size_t row = (size_t)(r0 + tb * 16 + c);
#pragma unroll
            for (int jb = 0; jb < 2; ++jb) { const int j = w * 32 + jb * 16 + q * 4;
                const u32x2 ru = *(const u32x2*)(PROJ + row * GLANP + 2048 + h * 256 + j);
                const f32x4 ng = jb ? ng1 : ng0;
                const float v0 = o[jb][tb][0] * rs * ng[0] * siluf(bflo(ru[0])), v1 = o[jb][tb][1] * rs * ng[1] * siluf(bfhi(ru[0]));
                const float v2 = o[jb][tb][2] * rs * ng[2] * siluf(bflo(ru[1])), v3 = o[jb][tb][3] * rs * ng[3] * siluf(bfhi(ru[1]));
                u32x2 u; u[0] = cvt_pk_bf16(v0, v1); u[1] = cvt_pk_bf16(v2, v3);
                *(u32x2*)(O + row * D + h * 256 + j) = u; } }
        __syncthreads();
    }
}

__device__ __forceinline__ void gla_sample_item(const Params& p, unsigned char* shm, int item) {
    const int tid = tidx(), lane = tid & 63, w = tid >> 6;
    const int b = item >> 2, h = item & 3;
    const bf16_t* PROJ = (const bf16_t*)(p.ws + WS_BIG);
    bf16_t* O = (bf16_t*)(p.ws + WS_H);
    float* A_ = (float*)shm; float* Q_ = A_ + 512; float* K_ = Q_ + 512; float* V_ = K_ + 512; float* OP = V_ + 1024; float* RED = OP + 2048;
    { const int i = tid & 127, t = tid >> 7; const size_t row = (size_t)(LP + b * 4 + t);
      float z = p.in[16][h * 128 + i];
#pragma unroll
      for (int j = 0; j < 16; ++j) z += bf2f(PROJ[row * GLANP + 3072 + j]) * p.in[15][j * 512 + h * 128 + i];
      A_[t * 128 + i] = __expf(log_sigmoid(z) * (1.f / 16.f));
      Q_[t * 128 + i] = bf2f(PROJ[row * GLANP + h * 128 + i]) * 0.08838834764831845f;
      K_[t * 128 + i] = bf2f(PROJ[row * GLANP + 512 + h * 128 + i]); }
#pragma unroll
    for (int e = 0; e < 2; ++e) { const int idx = tid + e * 512, t = idx >> 8, j = idx & 255; V_[idx] = bf2f(PROJ[(size_t)(LP + b * 4 + t) * GLANP + 1024 + h * 256 + j]); }
    __syncthreads();
    const int j = tid & 255, half = tid >> 8;
    const float v0 = V_[j], v1 = V_[256 + j], v2 = V_[512 + j], v3 = V_[768 + j];
    float o0 = 0.f, o1 = 0.f, o2 = 0.f, o3 = 0.f;
    const float* sin_ = p.in[4] + (size_t)(b * 4 + h) * 128 * 256; float* sout = p.out + O_GS + (size_t)(b * 4 + h) * 128 * 256;
#pragma unroll 8
    for (int ii = 0; ii < 64; ++ii) { const int i = half * 64 + ii;
        float S = sin_[i * 256 + j];
        S = A_[i] * S + K_[i] * v0; o0 += Q_[i] * S;
        S = A_[128 + i] * S + K_[128 + i] * v1; o1 += Q_[128 + i] * S;
        S = A_[256 + i] * S + K_[256 + i] * v2; o2 += Q_[256 + i] * S;
        S = A_[384 + i] * S + K_[384 + i] * v3; o3 += Q_[384 + i] * S;
        sout[i * 256 + j] = S; }
    OP[(half * 4 + 0) * 256 + j] = o0; OP[(half * 4 + 1) * 256 + j] = o1; OP[(half * 4 + 2) * 256 + j] = o2; OP[(half * 4 + 3) * 256 + j] = o3;
    __syncthreads();
    const int t0 = half * 2;
    const float a0 = OP[t0 * 256 + j] + OP[(4 + t0) * 256 + j], a1 = OP[(t0 + 1) * 256 + j] + OP[(4 + t0 + 1) * 256 + j];
    const float s0 = wave_sum(a0 * a0), s1 = wave_sum(a1 * a1);
    if (lane == 0) { RED[w * 2] = s0; RED[w * 2 + 1] = s1; }
    __syncthreads();
    const int wb = half * 4;
    const float q0 = RED[wb * 2] + RED[(wb + 1) * 2] + RED[(wb + 2) * 2] + RED[(wb + 3) * 2];
    const float q1 = RED[wb * 2 + 1] + RED[(wb + 1) * 2 + 1] + RED[(wb + 2) * 2 + 1] + RED[(wb + 3) * 2 + 1];
    const float ng = p.in[17][j];
    { const size_t row = (size_t)(LP + b * 4 + t0);
      const float r0v = bf2f(PROJ[row * GLANP + 2048 + h * 256 + j]), r1v = bf2f(PROJ[(row + 1) * GLANP + 2048 + h * 256 + j]);
      O[row * D + h * 256 + j] = (bf16_t)(cvt_pk_bf16(a0 * rsqrtf(q0 * (1.f / 256.f) + LN_EPS) * ng * siluf(r0v), 0.f) & 0xffffu);
      O[(row + 1) * D + h * 256 + j] = (bf16_t)(cvt_pk_bf16(a1 * rsqrtf(q1 * (1.f / 256.f) + LN_EPS) * ng * siluf(r1v), 0.f) & 0xffffu); }
    __syncthreads();
}

#define XB_TMO      128
#define XB_XCNT(j)  (256  + 64 * (j))
#define XB_XSUB(j)  (1280 + 64 * (j))
#define XB_XGEN(j)  (2304 + 64 * (j))
#define XB_TOP      3328
#define XB_TOPGEN   3392
#define XCD_BAR_WORDS 3456
#define XB_SPIN_CAP (1u << 18)

__device__ __forceinline__ unsigned xb_ld(unsigned* p)              { return __hip_atomic_load(p, __ATOMIC_RELAXED, __HIP_MEMORY_SCOPE_AGENT); }
__device__ __forceinline__ unsigned xb_add(unsigned* p, unsigned v) { return __hip_atomic_fetch_add(p, v, __ATOMIC_RELAXED, __HIP_MEMORY_SCOPE_AGENT); }
__device__ __forceinline__ unsigned xb_xcc_id() { return (unsigned)__builtin_amdgcn_s_getreg((3 << 11) | 20) & 0xFu; }
#define XB_SPIN(cond, bar) do { unsigned _sp = 0; while (cond) { __builtin_amdgcn_s_sleep(1); \
    if ((++_sp & 255u) == 0u) { if (xb_ld(&(bar)[XB_TMO])) break; if (_sp > XB_SPIN_CAP) { atomicAdd(&(bar)[XB_TMO], 1u); break; } } } } while (0)

struct XcdBarrier {
    unsigned* bar; unsigned x;
    volatile LAS unsigned* st;
};

__device__ __forceinline__ XcdBarrier xcd_barrier_post(unsigned* bar, volatile LAS unsigned* st) {
    XcdBarrier b; b.bar = bar; b.x = xb_xcc_id(); b.st = st;
    if (threadIdx.x == 0) (void)xb_add(&bar[XB_XCNT(b.x)], 1u);
    return b;
}
__device__ __forceinline__ void xcd_barrier_complete(unsigned* bar, unsigned x, unsigned& nloc, unsigned& nx) {
    const unsigned G = gridDim.x * gridDim.y * gridDim.z;
    unsigned sum, cnt, mine, sp = 0u;
    for (;;) {
        sum = 0u; cnt = 0u; mine = 0u;
#pragma unroll
        for (unsigned j = 0; j < 16; ++j) { const unsigned c = xb_ld(&bar[XB_XCNT(j)]); sum += c; cnt += (c > 0u) ? 1u : 0u; mine = (j == x) ? c : mine; }
        if (sum == G) break;
        __builtin_amdgcn_s_sleep(1);
        if ((++sp & 255u) == 0u) { if (xb_ld(&bar[XB_TMO])) break; if (sp > XB_SPIN_CAP) { atomicAdd(&bar[XB_TMO], 1u); break; } }
    }
    nloc = mine > 0u ? mine : 1u; nx = cnt > 0u ? cnt : 1u;
}

__device__ __forceinline__ void xcd_barrier(const XcdBarrier& b) {
    asm volatile("s_waitcnt vmcnt(0)" ::: "memory");
    __syncthreads();
    if (threadIdx.x == 0) {
        unsigned* bar = b.bar;
        __builtin_amdgcn_s_waitcnt(0);
        unsigned nloc = b.st[0], nx = b.st[1];
        if (nloc == 0u) { xcd_barrier_complete(bar, b.x, nloc, nx); b.st[0] = nloc; b.st[1] = nx; }
        const unsigned old = xb_add(&bar[XB_XSUB(b.x)], 1u);
        const unsigned gen = old / nloc;
        if (old + 1u == (gen + 1u) * nloc) {
            __builtin_amdgcn_fence(__ATOMIC_RELEASE, "agent");
            asm volatile("s_waitcnt vmcnt(0)" ::: "memory");
            const unsigned og = xb_add(&bar[XB_TOP], 1u);
            const unsigned tg = og / nx;
            if (og + 1u == (tg + 1u) * nx) xb_add(&bar[XB_TOPGEN], 1u);
            else XB_SPIN(xb_ld(&bar[XB_TOPGEN]) == tg, bar);
            __builtin_amdgcn_fence(__ATOMIC_ACQUIRE, "agent");
            xb_add(&bar[XB_XGEN(b.x)], 1u);
            asm volatile("s_waitcnt vmcnt(0)" ::: "memory");
        } else {
            XB_SPIN(xb_ld(&bar[XB_XGEN(b.x)]) == gen, bar);
            __builtin_amdgcn_fence(__ATOMIC_ACQUIRE, "agent");
            asm volatile("s_waitcnt vmcnt(0)" ::: "memory");
        }
    }
    __syncthreads();
}

#ifndef USE_XB
#define USE_XB 1
#endif
#ifndef REP_MASK
#define REP_MASK 0u
#endif
#ifndef EXTRA_SYNCS
#define EXTRA_SYNCS 0
#endif
#ifndef PROBE_LN
#define PROBE_LN 0
#endif
#ifndef PROBE_GS
#define PROBE_GS 0
#endif
#ifndef PROBE_W2
#define PROBE_W2 0
#endif
#ifndef ONLY_PH
#define ONLY_PH -1
#endif
#define PHSEL(n) (ONLY_PH < 0 || ONLY_PH == (n))
__global__ void __launch_bounds__(512, 2) mega(Params p) {
    extern __shared__ __attribute__((aligned(16))) unsigned char shm[];
    cg::grid_group grid = cg::this_grid();
    const int wg = blockIdx.x, nwg = gridDim.x;
    unsigned char* ws = p.ws;
    const float* MOD = (const float*)(ws + WS_MOD);
    bf16_t* Hb = (bf16_t*)(ws + WS_H);
    bf16_t* BIG = (bf16_t*)(ws + WS_BIG);
    LAS unsigned char* lds = (LAS unsigned char*)shm;
    volatile LAS unsigned* xst = (volatile LAS unsigned*)(lds + 131072);
    if (threadIdx.x == 0) { xst[0] = 0u; xst[1] = 0u; }
    __syncthreads();
    const XcdBarrier xb = xcd_barrier_post((unsigned*)(ws + WS_CTL), xst);
#define GSYNC() do { if (USE_XB) xcd_barrier(xb); else grid.sync(); } while (0)
#define PH(n) if (PHSEL(n))
    if (p.ph_lo == 0x7fffffff) grid.sync();
    PH(0) phase_prep(p, shm, wg, nwg, 0);
    GSYNC();
    PH(1) { pg8::Gemm g{(const bf16_t*)(ws + WS_CMAT), BIG, CPAD, MODN, D, D}; pg8::StaticOrder S; S.init(CPAD, MODN, nwg, wg);
            pg8::EpiF32 E{(float*)(ws + WS_MOD), MODN, p.in[8]}; pg8::gemm_phase(lds, g, S, E); }
    PH(0) if (wg >= 48) phase_prep(p, shm, wg - 48, nwg - 48, 1);
    GSYNC();
    PH(2) phase_mod0(p, wg, nwg);
    GSYNC();
#pragma unroll 1
    for (int l = 0; l < 2; ++l) {
        PH(3) { const int N = l ? GLANP : NQKV;
                pg8::Gemm g{Hb, (const bf16_t*)(ws + (l ? WS_WT_GIN : WS_WT_AIN)), R, N, D, D}; pg8::StaticOrder S; S.init(R, N, nwg, wg);
                pg8::EpiBf16 E{BIG, N, 0}; pg8::gemm_phase(lds, g, S, E); }
        PH(0) if (l == 0 && wg >= 140) phase_prep(p, shm, wg - 140, nwg - 140, 2);
        GSYNC();
        if (l == 0) {
            PH(4) for (int u = wg; u < 512 + 512; u += nwg) { if (u < 512) attn_prompt_unit(p, shm, u); else attn_sample_unit(p, shm, u - 512); }
            GSYNC();
        } else {
            PH(11) for (int u = wg; u < 256; u += nwg) gla_g1_item(p, shm, u);
            GSYNC();
            PH(12) { gla_g2(p, wg, nwg); for (int u = wg; u < 512; u += nwg) gla_sample_item(p, shm, u); }
            GSYNC();
            PH(13) for (int u = wg; u < 256; u += nwg) gla_g3_item(p, shm, u);
            GSYNC();
        }
        PH(5) { pg8::Gemm g{Hb, (const bf16_t*)(ws + (l ? WS_WT_GOUT : WS_WT_AOUT)), R, D, D, 256}; pg8::SplitOrder S; S.init(D, 4, nwg, wg);
                pg8::EpiResid E{p.out, l ? p.out : p.in[0], l ? p.out + (size_t)LP * D : p.in[1], MOD + (2 * l) * 3072 + 2048, (float*)(ws + WS_PART), nullptr,
                                l ? p.in[9] + 1 * D : nullptr, l ? p.in[10] + 1 * D : nullptr, (const float*)(ws + WS_STATS)}; pg8::gemm_phase(lds, g, S, E); }
        GSYNC();
        PH(6) phase_ln(p, 2 * l, 2 * l + 1, 4, 2 * l, wg, nwg);
        GSYNC();
        PH(7) { pg8::Gemm g{Hb, (const bf16_t*)(ws + WS_WT_W1) + (size_t)l * DFF * D, R, DFF, D, D}; pg8::StaticOrder S; S.init(R, DFF, nwg, wg);
                pg8::EpiBf16 E{BIG, DFF, 1}; pg8::gemm_phase(lds, g, S, E); }
        GSYNC();
        PH(8) { pg8::Gemm g{BIG, (const bf16_t*)(ws + WS_WT_W2) + (size_t)l * D * DFF, R, D, DFF, 256}; pg8::SplitOrder S; S.init(D, 16, nwg, wg);
                pg8::EpiResid E{p.out, p.out, p.out + (size_t)LP * D, MOD + (l * 2 + 1) * 3072 + 2048, (float*)(ws + WS_PART), nullptr, p.in[9] + (l * 2) * D, p.in[10] + (l * 2) * D, (const float*)(ws + WS_STATS)}; pg8::gemm_phase(lds, g, S, E); }
        GSYNC();
        PH(9) phase_ln(p, 2 * l + 1, l ? -1 : 2, 16, 2 * l + 1, wg, nwg);
        if (l == 0) GSYNC();
    }
}

#ifndef MK_ONE_LAUNCH
#define MK_ONE_LAUNCH 1
#endif

extern "C" void kernel_launch(void* const* d_in, const int* in_sizes, int n_in, void* d_out, int out_size, void* d_ws, size_t ws_size, hipStream_t stream) {
    static int grid = 0;
    if (grid == 0) {
        if (n_in != 21 || ws_size < WS_END) { fprintf(stderr, "kernel_launch: unexpected n_in %d or ws_size %zu (< %zu)\n", n_in, ws_size, (size_t)WS_END); grid = -1; return; }
        int dev = 0, cus = 0, per_cu = 0;
        hipGetDevice(&dev);
        hipDeviceGetAttribute(&cus, hipDeviceAttributeMultiprocessorCount, dev);
        if (hipFuncSetAttribute((const void*)mega, hipFuncAttributeMaxDynamicSharedMemorySize, LDS_BYTES) != hipSuccess) { fprintf(stderr, "kernel_launch: hipFuncSetAttribute failed\n"); grid = -1; return; }
        if (hipOccupancyMaxActiveBlocksPerMultiprocessor(&per_cu, (const void*)mega, 512, LDS_BYTES) != hipSuccess || per_cu < 1) { fprintf(stderr, "kernel_launch: occupancy query failed (%d)\n", per_cu); per_cu = 1; }
        (void)hipGetLastError();
        grid = cus * per_cu;
    }
    if (grid < 0) return;
    if (hipMemsetAsync((char*)d_ws + WS_CTL, 0, CTL_BYTES, stream) != hipSuccess) { fprintf(stderr, "kernel_launch: memset failed\n"); return; }
    Params p{};
    for (int i = 0; i < 21; ++i) p.in[i] = (const float*)d_in[i];
    p.out = (float*)d_out; p.ws = (unsigned char*)d_ws;
#if MK_ONE_LAUNCH
    p.ph_lo = 0; p.ph_hi = NPH;
    void* args[] = {&p};
    hipError_t e = hipLaunchCooperativeKernel((const void*)mega, dim3(grid), dim3(512), args, LDS_BYTES, stream);
    if (e != hipSuccess) fprintf(stderr, "cooperative launch failed: %s (grid %d)\n", hipGetErrorString(e), grid);
#else
    for (int ph = 0; ph < NPH; ++ph) {
        p.ph_lo = ph; p.ph_hi = ph + 1;
        hipLaunchKernelGGL(mega, dim3(grid), dim3(512), LDS_BYTES, stream, p);
    }
#endif
}
```

```cpp
#include <hip/hip_runtime.h>
#include <hip/hip_cooperative_groups.h>
#include <cstdio>
#include <cstdint>
namespace cg = cooperative_groups;

#define LAS __attribute__((address_space(3)))
typedef unsigned short bf16_t;
typedef short bf16x8 __attribute__((ext_vector_type(8)));
typedef float f32x4 __attribute__((ext_vector_type(4)));
typedef unsigned u32x4 __attribute__((ext_vector_type(4)));
typedef unsigned u32x2 __attribute__((ext_vector_type(2)));

constexpr int D = 1024, LP = 16384, NSEQ = 128, LS = 4, RS = NSEQ * LS, R = LP + RS;
constexpr int CPAD = 256, MODN = 12288;
constexpr int NQKV = 1536, GLAN = 3088, GLANP = 3328, DFF = 4096;
constexpr float ALPHA = 1.4142135623730951f;
constexpr float LN_EPS = 1e-5f;
constexpr int NPH = 19;
constexpr int LDS_BYTES = 131072 + 1024;

constexpr size_t O_Y = 0, O_KP = 17301504, O_VP = 17334272, O_GP = 17367040, O_KS = 17498112, O_VS = 21692416, O_GS = 25886720;
constexpr size_t WS_WT_AIN = 0;
constexpr size_t WS_WT_AOUT = WS_WT_AIN + (size_t)NQKV * D * 2;
constexpr size_t WS_WT_GIN = WS_WT_AOUT + (size_t)D * D * 2;
constexpr size_t WS_WT_GOUT = WS_WT_GIN + (size_t)GLANP * D * 2;
constexpr size_t WS_WT_W1 = WS_WT_GOUT + (size_t)D * D * 2;
constexpr size_t WS_WT_W2 = WS_WT_W1 + (size_t)2 * DFF * D * 2;
constexpr size_t WS_MOD = WS_WT_W2 + (size_t)2 * DFF * D * 2;
constexpr size_t WS_CMAT = WS_MOD + (size_t)CPAD * MODN * 4;
constexpr size_t WS_H = WS_CMAT + (size_t)CPAD * D * 2;
constexpr size_t WS_GST = WS_H + (size_t)R * D * 2;
constexpr size_t WS_PART = WS_GST;
constexpr size_t WS_GDEC = WS_GST + (size_t)64 * 4 * 256 * 128 * 4;
constexpr size_t WS_BIG = WS_GDEC + (size_t)64 * 4 * 128 * 4;
constexpr size_t WS_CTL = WS_BIG + (size_t)R * DFF * 2;
constexpr size_t CTL_BYTES = 16384;
constexpr size_t WS_STATS = WS_CTL + CTL_BYTES;
constexpr size_t WS_YB = WS_STATS + (size_t)R * 8;
constexpr size_t WS_END = WS_YB + (size_t)R * D * 2;

struct Params {
    const float* in[21];
    float* out;
    unsigned char* ws;
    int ph_lo, ph_hi;
};

typedef __bf16 bf16x2_t __attribute__((ext_vector_type(2)));
typedef float f32x2_t __attribute__((ext_vector_type(2)));
__device__ __forceinline__ unsigned cvt_pk_bf16(float lo, float hi) { const f32x2_t v = {lo, hi}; const bf16x2_t r = __builtin_convertvector(v, bf16x2_t); return __builtin_bit_cast(unsigned, r); }
__device__ __forceinline__ float bf2f(bf16_t b) { return __builtin_bit_cast(float, (unsigned)b << 16); }
__device__ __forceinline__ float bflo(unsigned u) { return __builtin_bit_cast(float, u << 16); }
__device__ __forceinline__ float bfhi(unsigned u) { return __builtin_bit_cast(float, u & 0xffff0000u); }
__device__ __forceinline__ int tidx() { int t = threadIdx.x; asm volatile("" : "+v"(t)); return t; }
typedef short s16x4 __attribute__((ext_vector_type(4)));
__device__ __forceinline__ bf16x8 tr_pair(const bf16_t* p0, const bf16_t* p1) {
    const s16x4 a = __builtin_amdgcn_ds_read_tr16_b64_v4i16((LAS s16x4*)p0), b = __builtin_amdgcn_ds_read_tr16_b64_v4i16((LAS s16x4*)p1);
    return (bf16x8){a[0], a[1], a[2], a[3], b[0], b[1], b[2], b[3]};
}
__device__ __forceinline__ float siluf(float x) { return x / (1.f + __expf(-x)); }
__device__ __forceinline__ float wave_sum(float v) {
#pragma unroll
    for (int o = 32; o > 0; o >>= 1) v += __shfl_xor(v, o, 64);
    return v;
}
__device__ __forceinline__ float wave_max(float v) {
#pragma unroll
    for (int o = 32; o > 0; o >>= 1) v = fmaxf(v, __shfl_xor(v, o, 64));
    return v;
}

namespace pg8 {
constexpr int BM = 256, BK = 64, HALF = 128, HTB = HALF * BK * 2, STAGE_BYTES = 8 * HTB, NXCD = 8, WGM = 8;
__host__ __device__ __forceinline__ int lds_byte(int r, int c) { const int st = (r >> 4) * 2 + (c >> 5), rr = r & 15, cc = c & 31, ob = rr * 64 + cc * 2; return st * 1024 + (ob ^ (((ob >> 9) & 1) << 5)); }
__host__ __device__ __forceinline__ void stage_rc(int b, int& Rr, int& C) { const int st = b / 1024, sb = b % 1024, swz = sb ^ (((sb >> 9) & 1) << 5); Rr = (st >> 1) * 16 + swz / 64; C = (st & 1) * 32 + (swz % 64) / 2; }
__host__ __device__ __forceinline__ int perm32(int rho) { const int n = rho >> 4, i = rho & 15; return 8 * (i >> 2) + 4 * n + (i & 3); }
struct Unit { int pm, pn, ks; };
struct Gemm { const bf16_t* A; const bf16_t* Bt; int M, N, K, Ksp; };
struct StaticOrder {
    int nM, nN, nwg, G, c;
    __host__ __device__ void init(int M, int N, int G_, int c_) { nM = M / BM; nN = N / BM; nwg = nM * nN; G = G_; c = c_; }
    __host__ __device__ bool next(int i, Unit& u) const {
        const long L = (long)i * G + c; if (L >= nwg) return false;
        int wgid = (int)L; { const int q = nwg / NXCD, r = nwg % NXCD, xcd = wgid % NXCD, off = wgid / NXCD; wgid = (xcd < r ? xcd * (q + 1) : r * (q + 1) + (xcd - r) * q) + off; }
        const int nig = WGM * nN, gid = wgid / nig, fm = gid * WGM, gsz = (nM - fm) < WGM ? (nM - fm) : WGM;
        u.pm = fm + ((wgid % nig) % gsz); u.pn = (wgid % nig) / gsz; u.ks = -1; return true;
    }
    __host__ __device__ int nextp(int i) const { Unit u; return next(i, u) ? (u.pm | (u.pn << 8)) : -1; }
    __device__ __forceinline__ void a_ready(const Unit&) const {}
    __device__ __forceinline__ void done(const Unit&) const {}
};
struct SplitOrder {
    StaticOrder P; int nN, nsplit, nsu;
    __host__ __device__ void init(int N, int nsplit_, int G_, int c_) { P.init(LP, N, G_, c_); nN = N / BM; nsplit = nsplit_; nsu = 2 * nN * nsplit; }
    __host__ __device__ bool next(int i, Unit& u) const {
        const long L = (long)i * P.G + P.c;
        if (L < P.nwg) return P.next(i, u);
        const int j = (int)(L - P.nwg); if (j >= nsu) return false;
        const int tile = j / nsplit; u.ks = j - tile * nsplit; u.pm = LP / BM + (tile & 1); u.pn = tile >> 1; return true;
    }
    __host__ __device__ int nextp(int i) const {
        const long L = (long)i * P.G + P.c;
        if (L < P.nwg) return P.nextp(i);
        const int j = (int)(L - P.nwg); if (j >= nsu) return -1;
        const int tile = j / nsplit;
        return (LP / BM + (tile & 1)) | ((tile >> 1) << 8) | ((j - tile * nsplit + 1) << 16);
    }
    __device__ __forceinline__ void a_ready(const Unit&) const {}
    __device__ __forceinline__ void done(const Unit&) const {}
};

struct EpiF32 {
    static constexpr bool PERM = false;
    float* C; int ldc; const float* bias;
    __device__ __forceinline__ void operator()(const f32x4 (&acc)[2][2][4][2], const Unit& u, int wr, int wc, int fr, int fq) const {
        const int row0 = u.pm * BM + wr * 64 + fr, col0 = u.pn * BM + wc * 32 + 4 * fq;
        f32x4 bv[2][2];
#pragma unroll
        for (int bj = 0; bj < 2; ++bj)
#pragma unroll
            for (int n = 0; n < 2; ++n) bv[bj][n] = *(const f32x4*)(bias + col0 + bj * HALF + n * 16);
#pragma unroll
        for (int ai = 0; ai < 2; ++ai)
#pragma unroll
            for (int m = 0; m < 4; ++m) { float* rowp = C + (size_t)(row0 + ai * HALF + m * 16) * ldc + col0;
#pragma unroll
                for (int bj = 0; bj < 2; ++bj)
#pragma unroll
                    for (int n = 0; n < 2; ++n) *(f32x4*)(rowp + bj * HALF + n * 16) = acc[ai][bj][m][n] + bv[bj][n]; }
    }
};
struct EpiBf16 {
    static constexpr bool PERM = true;
    bf16_t* O; int ldc; int act;
    __device__ __forceinline__ void operator()(const f32x4 (&acc)[2][2][4][2], const Unit& u, int wr, int wc, int fr, int fq) const {
        const int row0 = u.pm * BM + wr * 64 + fr, col0 = u.pn * BM + wc * 32 + 8 * fq;
#pragma unroll
        for (int ai = 0; ai < 2; ++ai)
#pragma unroll
            for (int m = 0; m < 4; ++m) { bf16_t* rowp = O + (size_t)(row0 + ai * HALF + m * 16) * ldc + col0;
#pragma unroll
                for (int bj = 0; bj < 2; ++bj) { f32x4 v0 = acc[ai][bj][m][0], v1 = acc[ai][bj][m][1];
                    if (act) {
#pragma unroll
                        for (int e = 0; e < 4; ++e) { float a = fmaxf(v0[e], 0.f), b = fmaxf(v1[e], 0.f); v0[e] = a * a; v1[e] = b * b; } }
                    u32x4 o; o[0] = cvt_pk_bf16(v0[0], v0[1]); o[1] = cvt_pk_bf16(v0[2], v0[3]); o[2] = cvt_pk_bf16(v1[0], v1[1]); o[3] = cvt_pk_bf16(v1[2], v1[3]);
                    *(u32x4*)(rowp + bj * HALF) = o; } }
    }
};
struct EpiResid {
    static constexpr bool PERM = true;
    bf16_t* Yb; const float* Xin; const float* gate; float* part; const float* lg; const float* lb; const float* stats;
    __device__ __forceinline__ void operator()(const f32x4 (&acc)[2][2][4][2], const Unit& u, int wr, int wc, int fr, int fq) const {
        const int row0 = u.pm * BM + wr * 64 + fr, col0 = u.pn * BM + wc * 32 + 8 * fq;
        if (u.ks >= 0) {
            float* pb = part + ((size_t)u.ks * RS + (row0 - LP)) * D + col0;
#pragma unroll
            for (int ai = 0; ai < 2; ++ai)
#pragma unroll
                for (int m = 0; m < 4; ++m)
#pragma unroll
                    for (int bj = 0; bj < 2; ++bj) { float* q = pb + (size_t)(ai * HALF + m * 16) * D + bj * HALF;
                        *(f32x4*)q = acc[ai][bj][m][0]; *(f32x4*)(q + 4) = acc[ai][bj][m][1]; }
            return;
        }
#pragma unroll
        for (int bj = 0; bj < 2; ++bj) {
            const int col = col0 + bj * HALF;
            const f32x4 g0 = *(const f32x4*)(gate + col), g1 = *(const f32x4*)(gate + col + 4);
            f32x4 l0 = (f32x4){1.f, 1.f, 1.f, 1.f}, l1 = l0, b0 = (f32x4){0.f, 0.f, 0.f, 0.f}, b1 = b0;
            if (!Xin) { l0 = *(const f32x4*)(lg + col); l1 = *(const f32x4*)(lg + col + 4); b0 = *(const f32x4*)(lb + col); b1 = *(const f32x4*)(lb + col + 4); }
#pragma unroll
            for (int r8 = 0; r8 < 8; ++r8) {
                const int row = row0 + (r8 >> 2) * HALF + (r8 & 3) * 16;
                bf16_t* yp = Yb + (size_t)row * D + col;
                f32x4 x0, x1;
                if (Xin) { x0 = *(const f32x4*)(Xin + (size_t)row * D + col); x1 = *(const f32x4*)(Xin + (size_t)row * D + col + 4); }
                else { const u32x4 yb = *(const u32x4*)yp; const float2 st = *(const float2*)(stats + 2 * (size_t)row);
                    x0 = (f32x4){bflo(yb[0]), bfhi(yb[0]), bflo(yb[1]), bfhi(yb[1])}; x1 = (f32x4){bflo(yb[2]), bfhi(yb[2]), bflo(yb[3]), bfhi(yb[3])};
                    x0 = (x0 - st.x) * st.y * l0 + b0; x1 = (x1 - st.x) * st.y * l1 + b1; }
                const f32x4 y0 = x0 * ALPHA + g0 * acc[r8 >> 2][bj][r8 & 3][0], y1 = x1 * ALPHA + g1 * acc[r8 >> 2][bj][r8 & 3][1];
                u32x4 o; o[0] = cvt_pk_bf16(y0[0], y0[1]); o[1] = cvt_pk_bf16(y0[2], y0[3]); o[2] = cvt_pk_bf16(y1[0], y1[1]); o[3] = cvt_pk_bf16(y1[2], y1[3]);
                *(u32x4*)yp = o; } }
    }
};

template <class Epi, class Sched>
__device__ __forceinline__ void gemm_phase(LAS unsigned char* lds, const Gemm g, const Sched& S, const Epi& E) {
    const int tid = tidx(), wid = __builtin_amdgcn_readfirstlane(tid >> 6), lane = tid & 63, wr = wid >> 2, wc = wid & 3, fr = lane & 15, fq = lane >> 4;
    const int K = g.K;
    unsigned voffA[2], voffB[2];
#pragma unroll
    for (int i = 0; i < 2; ++i) { int Rr, C; stage_rc(tid * 16 + i * 8192, Rr, C); const int Rb = Epi::PERM ? ((Rr & ~31) + perm32(Rr & 31)) : Rr;
        voffA[i] = (unsigned)(Rr * K + C) * 2u; voffB[i] = (unsigned)(Rb * K + C) * 2u; }
    const size_t kstep = (size_t)(BK * 2);
    const size_t hstep = (size_t)HALF * K * 2;
    const size_t tstep = 2 * hstep;
    const unsigned ldsw = (unsigned)wid * 1024u;
    const int aoff = lds_byte(wr * 64 + fr, fq * 8), boff = lds_byte(wc * 32 + fr, fq * 8);
#define PG8_SA(b, h) (((b) * 2 + (h)) * HTB)
#define PG8_SB(b, h) ((4 + (b) * 2 + (h)) * HTB)
#define PG8_STAGE(bufoff, gbase, voff) do { _Pragma("unroll") for (int _i = 0; _i < 2; ++_i) \
        __builtin_amdgcn_global_load_lds((const unsigned*)((const char*)(gbase) + (voff)[_i]), (LAS unsigned*)(lds + (bufoff) + ldsw + _i * 8192), 16, 0, 0); } while (0)
#define PG8_LDA(dst, b, h) do { _Pragma("unroll") for (int m = 0; m < 4; ++m) _Pragma("unroll") for (int k = 0; k < 2; ++k) dst[m][k] = *(const LAS bf16x8*)(lds + PG8_SA(b, h) + aoff + m * 2048 + k * 1024); } while (0)
#define PG8_LDB(dst, b, h) do { _Pragma("unroll") for (int n = 0; n < 2; ++n) _Pragma("unroll") for (int k = 0; k < 2; ++k) dst[n][k] = *(const LAS bf16x8*)(lds + PG8_SB(b, h) + boff + n * 2048 + k * 1024); } while (0)
#define PG8_MMA(ai, bj, At, Bt) do { __builtin_amdgcn_s_setprio(1); _Pragma("unroll") for (int m = 0; m < 4; ++m) _Pragma("unroll") for (int n = 0; n < 2; ++n) _Pragma("unroll") for (int k = 0; k < 2; ++k) \
        acc[ai][bj][m][n] = __builtin_amdgcn_mfma_f32_16x16x32_bf16(Bt[n][k], At[m][k], acc[ai][bj][m][n], 0, 0, 0); __builtin_amdgcn_s_setprio(0); } while (0)
#define PG8_WAIT_V(n) asm volatile("s_waitcnt vmcnt(" #n ")" ::: "memory")
#define PG8_WAIT_L(n) asm volatile("s_waitcnt lgkmcnt(" #n ")" ::: "memory")
#define PG8_BAR __builtin_amdgcn_s_barrier()
#define PG8_SCHED __builtin_amdgcn_sched_barrier(0)
    Unit cur, nxt; int ui = 0;
    { const int pk = S.nextp(0); if (pk < 0) return; cur.pm = pk & 255; cur.pn = (pk >> 8) & 255; cur.ks = (pk >> 16) - 1; }
    f32x4 acc[2][2][4][2];
#pragma unroll
    for (int a = 0; a < 2; ++a)
#pragma unroll
        for (int b = 0; b < 2; ++b)
#pragma unroll
            for (int m = 0; m < 4; ++m)
#pragma unroll
                for (int n = 0; n < 2; ++n) acc[a][b][m][n] = (f32x4){0.f, 0.f, 0.f, 0.f};
    bf16x8 At[4][2], B0[2][2], B1[2][2];
    const size_t ksb = (size_t)g.Ksp * 2;
    const char* cA = (const char*)g.A + (size_t)cur.pm * tstep + (cur.ks < 0 ? (size_t)0 : cur.ks * ksb); const char* cB = (const char*)g.Bt + (size_t)cur.pn * tstep + (cur.ks < 0 ? (size_t)0 : cur.ks * ksb);
    int nt = (cur.ks < 0 ? K : g.Ksp) / BK;
    S.a_ready(cur);
    PG8_STAGE(PG8_SB(0, 0), cB, voffB); PG8_STAGE(PG8_SA(0, 0), cA, voffA); PG8_STAGE(PG8_SB(0, 1), cB + hstep, voffB); PG8_STAGE(PG8_SA(0, 1), cA + hstep, voffA);
    if (wr == 1) PG8_BAR;
    PG8_WAIT_V(4); PG8_BAR;
    PG8_STAGE(PG8_SB(1, 0), cB + kstep, voffB); PG8_STAGE(PG8_SA(1, 0), cA + kstep, voffA); PG8_STAGE(PG8_SB(1, 1), cB + hstep + kstep, voffB);
    PG8_WAIT_V(6); PG8_BAR;
    for (;;) {
        const int npk = S.nextp(ui + 1); const bool has_next = npk >= 0; nxt.pm = npk & 255; nxt.pn = (npk >> 8) & 255; nxt.ks = (npk >> 16) - 1;
        const size_t nko = (has_next && nxt.ks >= 0) ? nxt.ks * ksb : (size_t)0;
        const char* nA = has_next ? (const char*)g.A + (size_t)nxt.pm * tstep + nko : cA; const char* nB = has_next ? (const char*)g.Bt + (size_t)nxt.pn * tstep + nko : cB;
        for (int t = 0; t < nt; t += 2) {
            const bool last = (t == nt - 2);
            const char* a1 = cA + (size_t)(t + 1) * kstep;
            const char* a2 = last ? nA : cA + (size_t)(t + 2) * kstep; const char* b2 = last ? nB : cB + (size_t)(t + 2) * kstep;
            const char* a3 = a2 + kstep; const char* b3 = b2 + kstep;
            if (last && has_next) S.a_ready(nxt);
            PG8_LDB(B0, 0, 0); PG8_SCHED; PG8_LDA(At, 0, 0); PG8_STAGE(PG8_SA(1, 1), a1 + hstep, voffA);
            PG8_WAIT_L(8); PG8_BAR; PG8_WAIT_L(0); PG8_MMA(0, 0, At, B0); PG8_BAR; PG8_SCHED;
            PG8_LDB(B1, 0, 1); PG8_STAGE(PG8_SB(0, 0), b2, voffB);
            PG8_BAR; PG8_WAIT_L(0); PG8_MMA(0, 1, At, B1); PG8_BAR;
            PG8_LDA(At, 0, 1); PG8_STAGE(PG8_SA(0, 0), a2, voffA);
            PG8_BAR; PG8_WAIT_L(0); PG8_MMA(1, 0, At, B0); PG8_BAR; PG8_SCHED;
            PG8_STAGE(PG8_SB(0, 1), b2 + hstep, voffB);
            PG8_WAIT_V(6); PG8_BAR; PG8_MMA(1, 1, At, B1); PG8_BAR;
            PG8_LDB(B0, 1, 0); PG8_SCHED; PG8_LDA(At, 1, 0); PG8_STAGE(PG8_SA(0, 1), a2 + hstep, voffA);
            PG8_WAIT_L(8); PG8_BAR; PG8_WAIT_L(0); PG8_MMA(0, 0, At, B0); PG8_BAR; PG8_SCHED;
            PG8_LDB(B1, 1, 1); PG8_STAGE(PG8_SB(1, 0), b3, voffB);
            PG8_BAR; PG8_WAIT_L(0); PG8_MMA(0, 1, At, B1); PG8_BAR;
            PG8_LDA(At, 1, 1); PG8_STAGE(PG8_SA(1, 0), a3, voffA);
            PG8_BAR; PG8_WAIT_L(0); PG8_MMA(1, 0, At, B0); PG8_BAR; PG8_SCHED;
            PG8_STAGE(PG8_SB(1, 1), b3 + hstep, voffB);
            PG8_WAIT_V(6); PG8_BAR; PG8_MMA(1, 1, At, B1); PG8_BAR;
        }
        E(acc, cur, wr, wc, fr, fq); S.done(cur);
        if (!has_next) break;
#pragma unroll
        for (int a = 0; a < 2; ++a)
#pragma unroll
            for (int b = 0; b < 2; ++b)
#pragma unroll
                for (int m = 0; m < 4; ++m)
#pragma unroll
                    for (int n = 0; n < 2; ++n) acc[a][b][m][n] = (f32x4){0.f, 0.f, 0.f, 0.f};
        cur = nxt; cA = nA; cB = nB; ++ui; nt = (cur.ks < 0 ? K : g.Ksp) / BK;
    }
    PG8_WAIT_V(0);
    if (wr == 0) PG8_BAR;
    PG8_BAR;
#undef PG8_SA
#undef PG8_SB
#undef PG8_STAGE
#undef PG8_LDA
#undef PG8_LDB
#undef PG8_MMA
#undef PG8_WAIT_V
#undef PG8_WAIT_L
#undef PG8_BAR
#undef PG8_SCHED
}
}

__device__ __forceinline__ void transpose_convert(const float* __restrict__ W, bf16_t* __restrict__ Wt, int K, int N, int Npad, float* tile, int wg, int nwg) {
    const int tid = tidx();
    const int tn_n = Npad / 256, tk_n = K / 64, ntl = tn_n * tk_n;
    for (int t = wg; t < ntl; t += nwg) {
        const int tn = t % tn_n, tk = t / tn_n;
        float v[32];
#pragma unroll
        for (int e = 0; e < 32; ++e) { const int idx = e * 512 + tid, r = idx >> 8, c = idx & 255; const int col = tn * 256 + c;
            v[e] = col < N ? W[(size_t)(tk * 64 + r) * N + col] : 0.f; }
#pragma unroll
        for (int e = 0; e < 32; ++e) { const int idx = e * 512 + tid, r = idx >> 8, c = idx & 255; tile[r * 257 + c] = v[e]; }
        __syncthreads();
#pragma unroll
        for (int e = 0; e < 4; ++e) { const int ch = e * 512 + tid, n = ch >> 3, kc = ch & 7;
            u32x4 o;
#pragma unroll
            for (int j = 0; j < 4; ++j) o[j] = cvt_pk_bf16(tile[(kc * 8 + 2 * j) * 257 + n], tile[(kc * 8 + 2 * j + 1) * 257 + n]);
            *(u32x4*)(Wt + (size_t)(tn * 256 + n) * K + tk * 64 + kc * 8) = o; }
        __syncthreads();
    }
}

__device__ __forceinline__ void phase_prep(const Params& p, unsigned char* shm, int wg, int nwg, int part) {
    float* tile = (float*)shm;
    unsigned char* ws = p.ws;
    if (part == 0) {
        for (int m = 0; m < 4; ++m)
            transpose_convert(p.in[7] + (size_t)m * D * 3072, (bf16_t*)(ws + WS_BIG) + (size_t)m * 3072 * D, D, 3072, 3072, tile, wg, nwg);
        transpose_convert(p.in[11], (bf16_t*)(ws + WS_WT_AIN), D, NQKV, NQKV, tile, wg, nwg);
        transpose_convert(p.in[12], (bf16_t*)(ws + WS_WT_AOUT), D, D, D, tile, wg, nwg);
        bf16_t* cm = (bf16_t*)(ws + WS_CMAT);
        for (int idx = wg * 512 + tidx(); idx < CPAD * D; idx += nwg * 512) {
            const int r = idx >> 10, c = idx & 1023;
            float v = 0.f;
            if (r == 0) v = siluf(p.in[5][c]); else if (r <= NSEQ) v = siluf(p.in[6][(size_t)(r - 1) * D + c]);
            cm[idx] = (bf16_t)(cvt_pk_bf16(v, 0.f) & 0xffffu);
        }
    } else if (part == 1) {
        for (int l = 0; l < 2; ++l) {
            transpose_convert(p.in[19] + (size_t)l * D * DFF, (bf16_t*)(ws + WS_WT_W1) + (size_t)l * DFF * D, D, DFF, DFF, tile, wg, nwg);
            transpose_convert(p.in[20] + (size_t)l * DFF * D, (bf16_t*)(ws + WS_WT_W2) + (size_t)l * D * DFF, DFF, D, D, tile, wg, nwg);
        }
    } else {
        transpose_convert(p.in[14], (bf16_t*)(ws + WS_WT_GIN), D, GLAN, GLANP, tile, wg, nwg);
        transpose_convert(p.in[18], (bf16_t*)(ws + WS_WT_GOUT), D, D, D, tile, wg, nwg);
    }
}

__device__ __forceinline__ int crow_of(int row) { return row < LP ? 0 : 1 + ((row - LP) >> 2); }

__device__ __forceinline__ void phase_mod0(const Params& p, int wg, int nwg) {
    const int tid = tidx(), lane = tid & 63, wave = tid >> 6;
    const float* mod = (const float*)(p.ws + WS_MOD);
    bf16_t* H = (bf16_t*)(p.ws + WS_H);
    f32x4 sh0[4], sc0[4];
#pragma unroll
    for (int k = 0; k < 4; ++k) { sh0[k] = *(const f32x4*)(mod + k * 256 + lane * 4); sc0[k] = *(const f32x4*)(mod + 1024 + k * 256 + lane * 4) + 1.f; }
#pragma unroll 2
    for (int row = wg * 8 + wave; row < R; row += nwg * 8) {
        const float* xr = row < LP ? p.in[0] + (size_t)row * D : p.in[1] + (size_t)(row - LP) * D;
        const float* mr = mod + (size_t)crow_of(row) * MODN;
#pragma unroll
        for (int k = 0; k < 4; ++k) { const int col = k * 256 + lane * 4;
            const f32x4 x = *(const f32x4*)(xr + col);
            f32x4 sh = sh0[k], sc = sc0[k];
            if (row >= LP) { sh = *(const f32x4*)(mr + col); sc = *(const f32x4*)(mr + 1024 + col) + 1.f; }
            const f32x4 h = x * sc + sh;
            u32x2 o; o[0] = cvt_pk_bf16(h[0], h[1]); o[1] = cvt_pk_bf16(h[2], h[3]);
            *(u32x2*)(H + (size_t)row * D + col) = o; }
    }
}

__device__ __forceinline__ void phase_ln(const Params& p, int lnidx, int nset, int nsplit, int gset, int wg, int nwg) {
    const int tid = tidx(), lane = tid & 63, wave = tid >> 6;
    const float* mod = (const float*)(p.ws + WS_MOD);
    bf16_t* H = (bf16_t*)(p.ws + WS_H);
    const bf16_t* Yb = (const bf16_t*)(p.ws + WS_YB);
    float* stats = (float*)(p.ws + WS_STATS);
    float* Y = p.out;
    const float* g = p.in[9] + lnidx * D; const float* b = p.in[10] + lnidx * D;
#define COLK(k) ((((k) >> 1) * 512) + lane * 8 + ((k) & 1) * 4)
    f32x4 gv[4], bv[4];
#pragma unroll
    for (int k = 0; k < 4; ++k) { gv[k] = *(const f32x4*)(g + COLK(k)); bv[k] = *(const f32x4*)(b + COLK(k)); }
    f32x4 gm[4], bm[4];
#pragma unroll
    for (int k = 0; k < 4; ++k) { gm[k] = gv[k]; bm[k] = bv[k];
        if (nset >= 0) { const f32x4 sh = *(const f32x4*)(mod + nset * 3072 + COLK(k)), sc = *(const f32x4*)(mod + nset * 3072 + 1024 + COLK(k)) + 1.f;
            gm[k] = gv[k] * sc; bm[k] = bv[k] * sc + sh; } }
    const int rstep = nwg * 8;
    u32x4 nv[2];
    { const int row0 = wg * 8 + wave;
      nv[0] = *(const u32x4*)(Yb + (size_t)row0 * D + lane * 8); nv[1] = *(const u32x4*)(Yb + (size_t)row0 * D + 512 + lane * 8); }
    for (int row = wg * 8 + wave; row < R; row += rstep) {
        float* yr = Y + (size_t)row * D;
        f32x4 v[4]; float s = 0.f;
        if (row < LP) {
#pragma unroll
            for (int k2 = 0; k2 < 2; ++k2) { v[2 * k2] = (f32x4){bflo(nv[k2][0]), bfhi(nv[k2][0]), bflo(nv[k2][1]), bfhi(nv[k2][1])};
                v[2 * k2 + 1] = (f32x4){bflo(nv[k2][2]), bfhi(nv[k2][2]), bflo(nv[k2][3]), bfhi(nv[k2][3])}; }
            if (row + rstep < LP) { nv[0] = *(const u32x4*)(Yb + (size_t)(row + rstep) * D + lane * 8); nv[1] = *(const u32x4*)(Yb + (size_t)(row + rstep) * D + 512 + lane * 8); }
        } else {
            const float* pr = (const float*)(p.ws + WS_PART) + (size_t)(row - LP) * D;
            const float* gr = mod + (size_t)crow_of(row) * MODN + gset * 3072 + 2048;
            float mu0 = 0.f, rs0 = 1.f;
            if (lnidx > 0) { const float2 st = *(const float2*)(stats + 2 * (size_t)row); mu0 = st.x; rs0 = st.y; }
#pragma unroll
            for (int k = 0; k < 4; ++k) { const int col = COLK(k);
                f32x4 a = *(const f32x4*)(pr + col);
#pragma unroll 3
                for (int sp = 1; sp < nsplit; ++sp) a = a + *(const f32x4*)(pr + (size_t)sp * RS * D + col);
                f32x4 x;
                if (lnidx == 0) x = *(const f32x4*)(p.in[1] + (size_t)(row - LP) * D + col);
                else x = (*(const f32x4*)(yr + col) - mu0) * rs0 * *(const f32x4*)(g - D + col) + *(const f32x4*)(b - D + col);
                v[k] = x * ALPHA + *(const f32x4*)(gr + col) * a;
                if (nset >= 0) *(f32x4*)(yr + col) = v[k]; }
        }
#pragma unroll
        for (int k = 0; k < 4; ++k) s += v[k][0] + v[k][1] + v[k][2] + v[k][3];
        const float mu = wave_sum(s) * (1.f / D);
        float q = 0.f;
#pragma unroll
        for (int k = 0; k < 4; ++k) { const f32x4 d = v[k] - mu; q += d[0] * d[0] + d[1] * d[1] + d[2] * d[2] + d[3] * d[3]; }
        const float rstd = rsqrtf(wave_sum(q) * (1.f / D) + LN_EPS);
        if (nset >= 0 && lane == 0) *(float2*)(stats + 2 * (size_t)row) = make_float2(mu, rstd);
        const float* mr = mod + (size_t)crow_of(row) * MODN + (nset >= 0 ? nset * 3072 : 0);
        if (nset < 0) {
#pragma unroll
            for (int k = 0; k < 4; ++k) *(f32x4*)(yr + COLK(k)) = (v[k] - mu) * rstd * gv[k] + bv[k];
        } else {
            f32x4 h[4];
#pragma unroll
            for (int k = 0; k < 4; ++k) { const int col = COLK(k);
                if (row < LP) h[k] = (v[k] - mu) * rstd * gm[k] + bm[k];
                else { const f32x4 x = (v[k] - mu) * rstd * gv[k] + bv[k]; const f32x4 sh = *(const f32x4*)(mr + col), sc = *(const f32x4*)(mr + 1024 + col); h[k] = x * (sc + 1.f) + sh; } }
#pragma unroll
            for (int k2 = 0; k2 < 2; ++k2) { u32x4 o; o[0] = cvt_pk_bf16(h[2 * k2][0], h[2 * k2][1]); o[1] = cvt_pk_bf16(h[2 * k2][2], h[2 * k2][3]);
                o[2] = cvt_pk_bf16(h[2 * k2 + 1][0], h[2 * k2 + 1][1]); o[3] = cvt_pk_bf16(h[2 * k2 + 1][2], h[2 * k2 + 1][3]);
                *(u32x4*)(H + (size_t)row * D + k2 * 512 + lane * 8) = o; }
        }
    }
#undef COLK
}

__device__ __forceinline__ void attn_prompt_unit(const Params& p, unsigned char* shm, int unit) {
    const int tid = tidx(), lane = tid & 63, w = tid >> 6, c = lane & 15, q = lane >> 4;
    const int nb = unit >> 2, hk = unit & 3;
    const bf16_t* QKV = (const bf16_t*)(p.ws + WS_BIG);
    bf16_t* O = (bf16_t*)(p.ws + WS_H);
    bf16_t* Ks = (bf16_t*)shm;
    bf16_t* Vs = (bf16_t*)(shm + 36864);
    const int rbase = nb * 128 - 128;
#pragma unroll
    for (int i = 0; i < 4; ++i) { const int ch = tid + i * 512, s = ch >> 3, cc = ch & 7; const int grow = rbase + s;
        u32x4 v = (u32x4){0u, 0u, 0u, 0u};
        if (grow >= 0) v = *(const u32x4*)(QKV + (size_t)grow * NQKV + 1024 + hk * 64 + cc * 8);
        *(u32x4*)(Ks + s * 72 + cc * 8) = v; }
#pragma unroll
    for (int i = 0; i < 4; ++i) { const int ch = tid + i * 512, sr = ch >> 3, cc = ch & 7; const int grow = rbase + sr;
        u32x4 v = (u32x4){0u, 0u, 0u, 0u};
        if (grow >= 0) v = *(const u32x4*)(QKV + (size_t)grow * NQKV + 1280 + hk * 64 + cc * 8);
        *(u32x4*)(Vs + sr * 72 + cc * 8) = v; }
    if (nb == 127) {
        float* ok = p.out + O_KP; float* ov = p.out + O_VP;
        for (int idx = tid; idx < 128 * 64; idx += 512) { const int s = idx >> 6, d = idx & 63; const size_t row = (size_t)(LP - 128 + s);
            ok[(s * 4 + hk) * 64 + d] = bf2f(QKV[row * NQKV + 1024 + hk * 64 + d]);
            ov[(s * 4 + hk) * 64 + d] = bf2f(QKV[row * NQKV + 1280 + hk * 64 + d]); }
    }
    __syncthreads();
    bf16x8 qn[2];
#pragma unroll
    for (int kk = 0; kk < 2; ++kk) qn[kk] = *(const bf16x8*)(QKV + (size_t)(nb * 128 + (w & 3) * 32 + c) * NQKV + (hk * 4 + (w >> 2)) * 64 + kk * 32 + q * 8);
#pragma unroll 1
    for (int it = 0; it < 4; ++it) {
        const int task = w + 8 * (it >> 1), tt = it & 1;
        const int hq = hk * 4 + (task >> 2), w0 = (task & 3) * 32;
        const float slope = exp2f(-0.5f * (float)(hq + 1));
        const float sink = p.in[13][hq];
        bf16x8 qf[2];
#pragma unroll
        for (int kk = 0; kk < 2; ++kk) qf[kk] = qn[kk];
        { const int it2 = it < 3 ? it + 1 : 3, task2 = w + 8 * (it2 >> 1), tt2 = it2 & 1, hq2 = hk * 4 + (task2 >> 2), w02 = (task2 & 3) * 32;
#pragma unroll
          for (int kk = 0; kk < 2; ++kk) qn[kk] = *(const bf16x8*)(QKV + (size_t)(nb * 128 + w02 + tt2 * 16 + c) * NQKV + hq2 * 64 + kk * 32 + q * 8); }
        f32x4 sc[10];
#pragma unroll
        for (int st = 0; st < 10; ++st) {
            sc[st] = (f32x4){0.f, 0.f, 0.f, 0.f};
#pragma unroll
            for (int kk = 0; kk < 2; ++kk) {
                const bf16x8 kf = *(const bf16x8*)(Ks + (w0 + st * 16 + c) * 72 + kk * 32 + q * 8);
                sc[st] = __builtin_amdgcn_mfma_f32_16x16x32_bf16(kf, qf[kk], sc[st], 0, 0, 0);
            }
        }
        float mx = sink;
        const int tq = w0 + tt * 16 + c;
#pragma unroll
        for (int st = 0; st < 10; ++st)
#pragma unroll
            for (int e = 0; e < 4; ++e) {
                const int s = w0 + st * 16 + q * 4 + e, dist = tq + 128 - s;
                const bool valid = dist >= 0 && dist <= 128 && (nb > 0 || s >= 128);
                const float v = valid ? sc[st][e] * 0.125f - slope * (float)dist : -INFINITY;
                sc[st][e] = v; mx = fmaxf(mx, v);
            }
        mx = fmaxf(mx, __shfl_xor(mx, 16, 64)); mx = fmaxf(mx, __shfl_xor(mx, 32, 64));
        float ssum = 0.f;
#pragma unroll
        for (int st = 0; st < 10; ++st)
#pragma unroll
            for (int e = 0; e < 4; ++e) { const float pv = __expf(sc[st][e] - mx); sc[st][e] = pv; ssum += pv; }
        ssum += __shfl_xor(ssum, 16, 64); ssum += __shfl_xor(ssum, 32, 64);
        const float linv = 1.f / (ssum + __expf(sink - mx));
        f32x4 o[4];
#pragma unroll
        for (int dt = 0; dt < 4; ++dt) o[dt] = (f32x4){0.f, 0.f, 0.f, 0.f};
#pragma unroll
        for (int pp = 0; pp < 5; ++pp) {
            u32x4 pu; pu[0] = cvt_pk_bf16(sc[2 * pp][0], sc[2 * pp][1]); pu[1] = cvt_pk_bf16(sc[2 * pp][2], sc[2 * pp][3]);
            pu[2] = cvt_pk_bf16(sc[2 * pp + 1][0], sc[2 * pp + 1][1]); pu[3] = cvt_pk_bf16(sc[2 * pp + 1][2], sc[2 * pp + 1][3]);
            const bf16x8 pf = __builtin_bit_cast(bf16x8, pu);
#pragma unroll
            for (int dt = 0; dt < 4; ++dt) {
                const bf16_t* vp = Vs + (w0 + 32 * pp + 4 * q + (c >> 2)) * 72 + dt * 16 + 4 * (c & 3);
                const bf16x8 vf = tr_pair(vp, vp + 16 * 72);
                o[dt] = __builtin_amdgcn_mfma_f32_16x16x32_bf16(vf, pf, o[dt], 0, 0, 0);
            }
        }
#pragma unroll
        for (int dt = 0; dt < 4; ++dt) {
            const f32x4 v = o[dt] * linv;
            u32x2 u; u[0] = cvt_pk_bf16(v[0], v[1]); u[1] = cvt_pk_bf16(v[2], v[3]);
            *(u32x2*)(O + (size_t)(nb * 128 + w0 + tt * 16 + c) * D + hq * 64 + dt * 16 + q * 4) = u;
        }
    }
    __syncthreads();
}

__device__ __forceinline__ void attn_sample_unit(const Params& p, unsigned char* shm, int unit) {
    const int tid = tidx(), lane = tid & 63, w = tid >> 6;
    const int b = unit >> 2, hk = unit & 3;
    const bf16_t* QKV = (const bf16_t*)(p.ws + WS_BIG);
    bf16_t* O = (bf16_t*)(p.ws + WS_H);
    float* Kf = (float*)shm;
    float* Vf = Kf + 132 * 65;
    float* Qf = Vf + 132 * 65;
    float* P = Qf + 16 * 64;
    const float* ck = p.in[2]; const float* cv = p.in[3];
    float* ok = p.out + O_KS; float* ov = p.out + O_VS;
    { f32x4 kq[4], vq[4];
#pragma unroll
      for (int e = 0; e < 4; ++e) { const int ch = tid + e * 512, j = ch >> 4, c4 = (ch & 15) * 4; const size_t src = ((size_t)(b * 128 + j) * 4 + hk) * 64 + c4;
          kq[e] = *(const f32x4*)(ck + src); vq[e] = *(const f32x4*)(cv + src); }
#pragma unroll
      for (int e = 0; e < 4; ++e) { const int ch = tid + e * 512, j = ch >> 4, c4 = (ch & 15) * 4;
#pragma unroll
          for (int x = 0; x < 4; ++x) { Kf[j * 65 + c4 + x] = kq[e][x]; Vf[j * 65 + c4 + x] = vq[e][x]; }
          if (j >= 4) { const size_t dst = ((size_t)(b * 128 + j - 4) * 4 + hk) * 64 + c4; *(f32x4*)(ok + dst) = kq[e]; *(f32x4*)(ov + dst) = vq[e]; } } }
    if (tid < 256) { const int t = tid >> 6, d = tid & 63; const size_t row = (size_t)(LP + b * 4 + t);
        const float kv = bf2f(QKV[row * NQKV + 1024 + hk * 64 + d]), vv = bf2f(QKV[row * NQKV + 1280 + hk * 64 + d]);
        Kf[(128 + t) * 65 + d] = kv; Vf[(128 + t) * 65 + d] = vv;
        const size_t dst = ((size_t)(b * 128 + 124 + t) * 4 + hk) * 64 + d; ok[dst] = kv; ov[dst] = vv; }
    for (int idx = tid; idx < 16 * 64; idx += 512) { const int row = idx >> 6, d = idx & 63, g = row >> 2, t = row & 3;
        Qf[idx] = bf2f(QKV[(size_t)(LP + b * 4 + t) * NQKV + (hk * 4 + g) * 64 + d]); }
    __syncthreads();
    for (int idx = tid; idx < 16 * 132; idx += 512) { const int row = idx / 132, j = idx - row * 132, g = row >> 2, t = row & 3;
        const int dist = t + 128 - j;
        float v = -INFINITY;
        if (dist >= 0 && dist <= 128) {
            float a = 0.f;
#pragma unroll 16
            for (int d = 0; d < 64; ++d) a += Qf[row * 64 + d] * Kf[j * 65 + d];
            v = a * 0.125f - exp2f(-0.5f * (float)(hk * 4 + g + 1)) * (float)dist; }
        P[row * 136 + j] = v; }
    __syncthreads();
#pragma unroll
    for (int rr = 0; rr < 2; ++rr) { const int row = w * 2 + rr, g = row >> 2;
        const float sink = p.in[13][hk * 4 + g];
        float v0 = P[row * 136 + lane], v1 = P[row * 136 + 64 + lane], v2 = lane < 4 ? P[row * 136 + 128 + lane] : -INFINITY;
        const float m = fmaxf(wave_max(fmaxf(fmaxf(v0, v1), v2)), sink);
        v0 = __expf(v0 - m); v1 = __expf(v1 - m); v2 = __expf(v2 - m);
        const float inv = 1.f / (wave_sum(v0 + v1 + v2) + __expf(sink - m));
        P[row * 136 + lane] = v0 * inv; P[row * 136 + 64 + lane] = v1 * inv; if (lane < 4) P[row * 136 + 128 + lane] = v2 * inv; }
    __syncthreads();
#pragma unroll
    for (int rr = 0; rr < 2; ++rr) { const int idx = tid + rr * 512, row = idx >> 6, d = idx & 63, g = row >> 2, t = row & 3;
        float a = 0.f;
        for (int j = 0; j < 132; ++j) a += P[row * 136 + j] * Vf[j * 65 + d];
        O[(size_t)(LP + b * 4 + t) * D + (hk * 4 + g) * 64 + d] = (bf16_t)(cvt_pk_bf16(a, 0.f) & 0xffffu); }
    __syncthreads();
}

constexpr int G_QD = 0;
constexpr int G_KD = 17408;
constexpr int G_KDT = 34816;
constexpr int G_VT = 53248;
constexpr int G_AM = 90112;
constexpr int G_GD = 99328;
constexpr int G_EBC = 103424;
constexpr int G_SEG = 103936;
constexpr int G_RED = 105984;

__device__ __forceinline__ float log_sigmoid(float z) { return fminf(z, 0.f) - __logf(1.f + __expf(-fabsf(z))); }

template <bool FULL>
__device__ __forceinline__ float gla_preamble(const bf16_t* PROJ, unsigned char* shm, int r0, int h, const float (&wup)[16], float bg) {
    const int tid = tidx();
    bf16_t* QD = (bf16_t*)(shm + G_QD); bf16_t* KD = (bf16_t*)(shm + G_KD); bf16_t* KDT = (bf16_t*)(shm + G_KDT); bf16_t* VT = (bf16_t*)(shm + G_VT);
    float* GD = (float*)(shm + G_GD); float* EBC = (float*)(shm + G_EBC); float* SEG = (float*)(shm + G_SEG);
#pragma unroll
    for (int e = 0; e < 2; ++e) { const int idx = tid + e * 512, t = idx >> 4, j = idx & 15; GD[idx] = bf2f(PROJ[(size_t)(r0 + t) * GLANP + 3072 + j]); }
    const int i = tid & 127, seg = tid >> 7;
    unsigned short kraw[16], qraw[16];
#pragma unroll
    for (int tt = 0; tt < 16; ++tt) { const size_t rr = (size_t)(r0 + seg * 16 + tt) * GLANP + h * 128 + i; kraw[tt] = PROJ[rr + 512]; if (FULL) qraw[tt] = PROJ[rr]; }
#pragma unroll
    for (int e = 0; e < 4; ++e) { const int ch = tid + e * 512, t = ch >> 5, cc = ch & 31;
        *(u32x4*)(VT + t * 264 + cc * 8) = *(const u32x4*)(PROJ + (size_t)(r0 + t) * GLANP + 1024 + h * 256 + cc * 8); }
    __syncthreads();
    float bl[16]; float run = 0.f;
#pragma unroll
    for (int tt = 0; tt < 16; ++tt) { const int t = seg * 16 + tt; float z = bg;
#pragma unroll
        for (int j = 0; j < 16; ++j) z += GD[t * 16 + j] * wup[j];
        run += log_sigmoid(z) * (1.f / 16.f); bl[tt] = run; }
    SEG[seg * 128 + i] = run;
    __syncthreads();
    float pre = 0.f, tot = 0.f;
#pragma unroll
    for (int s = 0; s < 4; ++s) { const float v = SEG[s * 128 + i]; tot += v; if (s < seg) pre += v; }
    float kdv[16];
#pragma unroll
    for (int tt = 0; tt < 16; ++tt) { const int t = seg * 16 + tt; const float bt = pre + bl[tt];
        const float kv = bf2f(kraw[tt]);
        kdv[tt] = kv * __expf(tot - bt);
        if (FULL) {
            const float qv = bf2f(qraw[tt]) * 0.08838834764831845f;
            QD[t * 136 + i] = (bf16_t)(cvt_pk_bf16(qv * __expf(bt), 0.f) & 0xffffu);
            KD[t * 136 + i] = (bf16_t)(cvt_pk_bf16(kv * __expf(-bt), 0.f) & 0xffffu);
        } }
    { u32x4 v0, v1;
      v0[0] = cvt_pk_bf16(kdv[0], kdv[1]); v0[1] = cvt_pk_bf16(kdv[2], kdv[3]); v0[2] = cvt_pk_bf16(kdv[4], kdv[5]); v0[3] = cvt_pk_bf16(kdv[6], kdv[7]);
      v1[0] = cvt_pk_bf16(kdv[8], kdv[9]); v1[1] = cvt_pk_bf16(kdv[10], kdv[11]); v1[2] = cvt_pk_bf16(kdv[12], kdv[13]); v1[3] = cvt_pk_bf16(kdv[14], kdv[15]);
      *(u32x4*)(KDT + i * 72 + seg * 16) = v0; *(u32x4*)(KDT + i * 72 + seg * 16 + 8) = v1; }
    if (seg == 0) EBC[i] = __expf(tot);
    __syncthreads();
    return tot;
}

__device__ __forceinline__ void gla_state_update(f32x4 (&S)[8][2], unsigned char* shm, int w, int c, int q) {
    const bf16_t* KDT = (const bf16_t*)(shm + G_KDT); const bf16_t* VT = (const bf16_t*)(shm + G_VT); const float* EBC = (const float*)(shm + G_EBC);
#pragma unroll
    for (int ib = 0; ib < 8; ++ib) { const f32x4 eb = *(const f32x4*)(EBC + ib * 16 + q * 4); S[ib][0] = S[ib][0] * eb; S[ib][1] = S[ib][1] * eb; }
#pragma unroll
    for (int kk = 0; kk < 2; ++kk) {
        bf16x8 vf[2];
#pragma unroll
        for (int jb = 0; jb < 2; ++jb) { const bf16_t* vp = VT + (kk * 32 + 8 * q + (c >> 2)) * 264 + w * 32 + jb * 16 + 4 * (c & 3); vf[jb] = tr_pair(vp, vp + 4 * 264); }
#pragma unroll
        for (int ib = 0; ib < 8; ++ib) { const bf16x8 kf = *(const bf16x8*)(KDT + (ib * 16 + c) * 72 + kk * 32 + q * 8);
            S[ib][0] = __builtin_amdgcn_mfma_f32_16x16x32_bf16(kf, vf[0], S[ib][0], 0, 0, 0);
            S[ib][1] = __builtin_amdgcn_mfma_f32_16x16x32_bf16(kf, vf[1], S[ib][1], 0, 0, 0); }
    }
}

__device__ __forceinline__ void gla_g1_item(const Params& p, unsigned char* shm, int item) {
    const int tid = tidx(), lane = tid & 63, w = tid >> 6, c = lane & 15, q = lane >> 4;
    const int sc = item >> 2, h = item & 3;
    const bf16_t* PROJ = (const bf16_t*)(p.ws + WS_BIG);
    float* GST = (float*)(p.ws + WS_GST); float* GDEC = (float*)(p.ws + WS_GDEC);
    float wup[16]; const int i = tid & 127;
#pragma unroll
    for (int j = 0; j < 16; ++j) wup[j] = p.in[15][j * 512 + h * 128 + i];
    const float bg = p.in[16][h * 128 + i];
    f32x4 S[8][2];
#pragma unroll
    for (int ib = 0; ib < 8; ++ib) { S[ib][0] = (f32x4){0.f, 0.f, 0.f, 0.f}; S[ib][1] = (f32x4){0.f, 0.f, 0.f, 0.f}; }
    float dec = 0.f;
#pragma unroll 1
    for (int ch = 0; ch < 4; ++ch) {
        dec += gla_preamble<false>(PROJ, shm, sc * 256 + ch * 64, h, wup, bg);
        gla_state_update(S, shm, w, c, q);
        __syncthreads();
    }
    float* dst = GST + (size_t)(sc * 4 + h) * 256 * 128;
#pragma unroll
    for (int ib = 0; ib < 8; ++ib)
#pragma unroll
        for (int jb = 0; jb < 2; ++jb) *(f32x4*)(dst + (size_t)(w * 32 + jb * 16 + c) * 128 + ib * 16 + q * 4) = S[ib][jb];
    if (tid < 128) GDEC[(sc * 4 + h) * 128 + tid] = dec;
}

__device__ __forceinline__ void gla_g2(const Params& p, int wg, int nwg) {
    float* GST = (float*)(p.ws + WS_GST); const float* GDEC = (const float*)(p.ws + WS_GDEC);
    float* og = p.out + O_GP;
    for (int idx = wg * 512 + tidx(); idx < 4 * 256 * 128; idx += nwg * 512) {
        const int h = idx >> 15, j = (idx >> 7) & 255, i = idx & 127;
        float S = 0.f;
        for (int s0 = 0; s0 < 64; s0 += 32) {
            float d[32], a[32];
#pragma unroll
            for (int k = 0; k < 32; ++k) { d[k] = GST[((size_t)((s0 + k) * 4 + h) * 256 + j) * 128 + i]; a[k] = GDEC[((s0 + k) * 4 + h) * 128 + i]; }
#pragma unroll
            for (int k = 0; k < 32; ++k) { GST[((size_t)((s0 + k) * 4 + h) * 256 + j) * 128 + i] = S; S = __expf(a[k]) * S + d[k]; }
        }
        og[(h * 128 + i) * 256 + j] = S;
    }
}

__device__ __forceinline__ void gla_g3_item(const Params& p, unsigned char* shm, int item) {
    const int tid = tidx(), lane = tid & 63, w = tid >> 6, c = lane & 15, q = lane >> 4;
    const int sc = item >> 2, h = item & 3;
    const bf16_t* PROJ = (const bf16_t*)(p.ws + WS_BIG);
    bf16_t* O = (bf16_t*)(p.ws + WS_H);
    const float* GST = (const float*)(p.ws + WS_GST);
    const bf16_t* QD = (const bf16_t*)(shm + G_QD); const bf16_t* KD = (const bf16_t*)(shm + G_KD); const bf16_t* VT = (const bf16_t*)(shm + G_VT);
    bf16_t* AM = (bf16_t*)(shm + G_AM); float* RED = (float*)(shm + G_RED);
    float wup[16]; const int i = tid & 127;
#pragma unroll
    for (int j = 0; j < 16; ++j) wup[j] = p.in[15][j * 512 + h * 128 + i];
    const float bg = p.in[16][h * 128 + i];
    f32x4 S[8][2];
    { const float* src = GST + (size_t)(sc * 4 + h) * 256 * 128;
#pragma unroll
      for (int ib = 0; ib < 8; ++ib)
#pragma unroll
          for (int jb = 0; jb < 2; ++jb) S[ib][jb] = *(const f32x4*)(src + (size_t)(w * 32 + jb * 16 + c) * 128 + ib * 16 + q * 4); }
    const f32x4 ng0 = *(const f32x4*)(p.in[17] + w * 32 + q * 4), ng1 = *(const f32x4*)(p.in[17] + w * 32 + 16 + q * 4);
#pragma unroll 1
    for (int ch = 0; ch < 4; ++ch) {
        const int r0 = sc * 256 + ch * 64;
        gla_preamble<true>(PROJ, shm, r0, h, wup, bg);
        { const int tb = w >> 1;
#pragma unroll
          for (int x = 0; x < 2; ++x) { const int sb = (w & 1) * 2 + x;
              f32x4 a = (f32x4){0.f, 0.f, 0.f, 0.f};
              if (sb <= tb) {
#pragma unroll
                  for (int kk = 0; kk < 4; ++kk) { const bf16x8 af = *(const bf16x8*)(QD + (tb * 16 + c) * 136 + kk * 32 + q * 8), bfv = *(const bf16x8*)(KD + (sb * 16 + c) * 136 + kk * 32 + q * 8);
                      a = __builtin_amdgcn_mfma_f32_16x16x32_bf16(af, bfv, a, 0, 0, 0); } }
#pragma unroll
              for (int e = 0; e < 4; ++e) { const int t = tb * 16 + q * 4 + e, s = sb * 16 + c;
                  AM[t * 72 + s] = (bf16_t)(cvt_pk_bf16(s <= t ? a[e] : 0.f, 0.f) & 0xffffu); } } }
        __syncthreads();
        f32x4 o[2][4];
#pragma unroll
        for (int jb = 0; jb < 2; ++jb)
#pragma unroll
            for (int tb = 0; tb < 4; ++tb) o[jb][tb] = (f32x4){0.f, 0.f, 0.f, 0.f};
#pragma unroll
        for (int pp = 0; pp < 4; ++pp) {
            bf16x8 sf[2];
#pragma unroll
            for (int jb = 0; jb < 2; ++jb) { u32x4 u;
                u[0] = cvt_pk_bf16(S[2 * pp][jb][0], S[2 * pp][jb][1]); u[1] = cvt_pk_bf16(S[2 * pp][jb][2], S[2 * pp][jb][3]);
                u[2] = cvt_pk_bf16(S[2 * pp + 1][jb][0], S[2 * pp + 1][jb][1]); u[3] = cvt_pk_bf16(S[2 * pp + 1][jb][2], S[2 * pp + 1][jb][3]);
                sf[jb] = __builtin_bit_cast(bf16x8, u); }
#pragma unroll
            for (int tb = 0; tb < 4; ++tb) { const bf16_t* qp = QD + (tb * 16 + c) * 136 + 32 * pp + 4 * q;
                const u32x2 a = *(const u32x2*)qp, b = *(const u32x2*)(qp + 16); u32x4 u; u[0] = a[0]; u[1] = a[1]; u[2] = b[0]; u[3] = b[1];
                const bf16x8 qf = __builtin_bit_cast(bf16x8, u);
                o[0][tb] = __builtin_amdgcn_mfma_f32_16x16x32_bf16(sf[0], qf, o[0][tb], 0, 0, 0);
                o[1][tb] = __builtin_amdgcn_mfma_f32_16x16x32_bf16(sf[1], qf, o[1][tb], 0, 0, 0); }
        }
#pragma unroll
        for (int kk = 0; kk < 2; ++kk) {
            bf16x8 vf[2];
#pragma unroll
            for (int jb = 0; jb < 2; ++jb) { const bf16_t* vp = VT + (kk * 32 + 8 * q + (c >> 2)) * 264 + w * 32 + jb * 16 + 4 * (c & 3); vf[jb] = tr_pair(vp, vp + 4 * 264); }
#pragma unroll
            for (int tb = 0; tb < 4; ++tb) { const bf16x8 af = *(const bf16x8*)(AM + (tb * 16 + c) * 72 + kk * 32 + q * 8);
                o[0][tb] = __builtin_amdgcn_mfma_f32_16x16x32_bf16(vf[0], af, o[0][tb], 0, 0, 0);
                o[1][tb] = __builtin_amdgcn_mfma_f32_16x16x32_bf16(vf[1], af, o[1][tb], 0, 0, 0); }
        }
        gla_state_update(S, shm, w, c, q);
#pragma unroll
        for (int tb = 0; tb < 4; ++tb) { float s = 0.f;
#pragma unroll
            for (int jb = 0; jb < 2; ++jb)
#pragma unroll
                for (int e = 0; e < 4; ++e) s += o[jb][tb][e] * o[jb][tb][e];
            s += __shfl_xor(s, 16, 64); s += __shfl_xor(s, 32, 64);
            if (q == 0) RED[w * 64 + tb * 16 + c] = s; }
        __syncthreads();
#pragma unroll
        for (int tb = 0; tb < 4; ++tb) { float s = 0.f;
#pragma unroll
            for (int ww = 0; ww < 8; ++ww) s += RED[ww * 64 + tb * 16 + c];
            const float rs = rsqrtf(s * (1.f / 256.f) + LN_EPS);
            const size_t row = (size_t)(r0 + tb * 16 + c);
#pragma unroll
            for (int jb = 0; jb < 2; ++jb) { const int j = w * 32 + jb * 16 + q * 4;
                const u32x2 ru = *(const u32x2*)(PROJ + row * GLANP + 2048 + h * 256 + j);
                const f32x4 ng = jb ? ng1 : ng0;
                const float v0 = o[jb][tb][0] * rs * ng[0] * siluf(bflo(ru[0])), v1 = o[jb][tb][1] * rs * ng[1] * siluf(bfhi(ru[0]));
                const float v2 = o[jb][tb][2] * rs * ng[2] * siluf(bflo(ru[1])), v3 = o[jb][tb][3] * rs * ng[3] * siluf(bfhi(ru[1]));
                u32x2 u; u[0] = cvt_pk_bf16(v0, v1); u[1] = cvt_pk_bf16(v2, v3);
                *(u32x2*)(O + row * D + h * 256 + j) = u; } }
        __syncthreads();
    }
}

__device__ __forceinline__ void gla_sample_item(const Params& p, unsigned char* shm, int item) {
    const int tid = tidx(), lane = tid & 63, w = tid >> 6;
    const int b = item >> 2, h = item & 3;
    const bf16_t* PROJ = (const bf16_t*)(p.ws + WS_BIG);
    bf16_t* O = (bf16_t*)(p.ws + WS_H);
    float* A_ = (float*)shm; float* Q_ = A_ + 512; float* K_ = Q_ + 512; float* V_ = K_ + 512; float* OP = V_ + 1024; float* RED = OP + 8192;
    { const int i = tid & 127, t = tid >> 7; const size_t row = (size_t)(LP + b * 4 + t);
      float z = p.in[16][h * 128 + i];
#pragma unroll
      for (int j = 0; j < 16; ++j) z += bf2f(PROJ[row * GLANP + 3072 + j]) * p.in[15][j * 512 + h * 128 + i];
      A_[t * 128 + i] = __expf(log_sigmoid(z) * (1.f / 16.f));
      Q_[t * 128 + i] = bf2f(PROJ[row * GLANP + h * 128 + i]) * 0.08838834764831845f;
      K_[t * 128 + i] = bf2f(PROJ[row * GLANP + 512 + h * 128 + i]); }
#pragma unroll
    for (int e = 0; e < 2; ++e) { const int idx = tid + e * 512, t = idx >> 8, j = idx & 255; V_[idx] = bf2f(PROJ[(size_t)(LP + b * 4 + t) * GLANP + 1024 + h * 256 + j]); }
    __syncthreads();
    const float* sin_ = p.in[4] + (size_t)(b * 4 + h) * 128 * 256; float* sout = p.out + O_GS + (size_t)(b * 4 + h) * 128 * 256;
    {
      const int jq = tid & 63, ig = tid >> 6;
      f32x4 vv[4], oo[4];
#pragma unroll
      for (int t = 0; t < 4; ++t) { vv[t] = *(const f32x4*)(V_ + t * 256 + 4 * jq); oo[t] = (f32x4){0.f, 0.f, 0.f, 0.f}; }
      const float* sp = sin_ + (size_t)(ig * 16) * 256 + 4 * jq; float* so = sout + (size_t)(ig * 16) * 256 + 4 * jq;
      f32x4 S[16];
#pragma unroll
      for (int ii = 0; ii < 16; ++ii) S[ii] = *(const f32x4*)(sp + ii * 256);
#pragma unroll
      for (int ii = 0; ii < 16; ++ii) { const int i = ig * 16 + ii;
#pragma unroll
          for (int t = 0; t < 4; ++t) { S[ii] = S[ii] * A_[t * 128 + i] + vv[t] * K_[t * 128 + i]; oo[t] = oo[t] + S[ii] * Q_[t * 128 + i]; }
          *(f32x4*)(so + ii * 256) = S[ii]; }
#pragma unroll
      for (int t = 0; t < 4; ++t) *(f32x4*)(OP + (ig * 4 + t) * 256 + 4 * jq) = oo[t]; }
    __syncthreads();
    const int j = tid & 255, half = tid >> 8;
    const int t0 = half * 2;
    float a0 = 0.f, a1 = 0.f;
#pragma unroll
    for (int g8 = 0; g8 < 8; ++g8) { a0 += OP[(g8 * 4 + t0) * 256 + j]; a1 += OP[(g8 * 4 + t0 + 1) * 256 + j]; }
    const float s0 = wave_sum(a0 * a0), s1 = wave_sum(a1 * a1);
    if (lane == 0) { RED[w * 2] = s0; RED[w * 2 + 1] = s1; }
    __syncthreads();
    const int wb = half * 4;
    const float q0 = RED[wb * 2] + RED[(wb + 1) * 2] + RED[(wb + 2) * 2] + RED[(wb + 3) * 2];
    const float q1 = RED[wb * 2 + 1] + RED[(wb + 1) * 2 + 1] + RED[(wb + 2) * 2 + 1] + RED[(wb + 3) * 2 + 1];
    const float ng = p.in[17][j];
    { const size_t row = (size_t)(LP + b * 4 + t0);
      const float r0v = bf2f(PROJ[row * GLANP + 2048 + h * 256 + j]), r1v = bf2f(PROJ[(row + 1) * GLANP + 2048 + h * 256 + j]);
      O[row * D + h * 256 + j] = (bf16_t)(cvt_pk_bf16(a0 * rsqrtf(q0 * (1.f / 256.f) + LN_EPS) * ng * siluf(r0v), 0.f) & 0xffffu);
      O[(row + 1) * D + h * 256 + j] = (bf16_t)(cvt_pk_bf16(a1 * rsqrtf(q1 * (1.f / 256.f) + LN_EPS) * ng * siluf(r1v), 0.f) & 0xffffu); }
    __syncthreads();
}

#define XB_TMO      128
#define XB_XCNT(j)  (256  + 64 * (j))
#define XB_XSUB(j)  (1280 + 64 * (j))
#define XB_XGEN(j)  (2304 + 64 * (j))
#define XB_TOP      3328
#define XB_TOPGEN   3392
#define XCD_BAR_WORDS 3456
#define XB_SPIN_CAP (1u << 18)

__device__ __forceinline__ unsigned xb_ld(unsigned* p)              { return __hip_atomic_load(p, __ATOMIC_RELAXED, __HIP_MEMORY_SCOPE_AGENT); }
__device__ __forceinline__ unsigned xb_add(unsigned* p, unsigned v) { return __hip_atomic_fetch_add(p, v, __ATOMIC_RELAXED, __HIP_MEMORY_SCOPE_AGENT); }
__device__ __forceinline__ unsigned xb_xcc_id() { return (unsigned)__builtin_amdgcn_s_getreg((3 << 11) | 20) & 0xFu; }
#define XB_SPIN(cond, bar) do { unsigned _sp = 0; while (cond) { __builtin_amdgcn_s_sleep(1); \
    if ((++_sp & 255u) == 0u) { if (xb_ld(&(bar)[XB_TMO])) break; if (_sp > XB_SPIN_CAP) { atomicAdd(&(bar)[XB_TMO], 1u); break; } } } } while (0)

struct XcdBarrier {
    unsigned* bar; unsigned x;
    volatile LAS unsigned* st;
};

__device__ __forceinline__ XcdBarrier xcd_barrier_post(unsigned* bar, volatile LAS unsigned* st) {
    XcdBarrier b; b.bar = bar; b.x = xb_xcc_id(); b.st = st;
    if (threadIdx.x == 0) (void)xb_add(&bar[XB_XCNT(b.x)], 1u);
    return b;
}
__device__ __forceinline__ void xcd_barrier_complete(unsigned* bar, unsigned x, unsigned& nloc, unsigned& nx) {
    const unsigned G = gridDim.x * gridDim.y * gridDim.z;
    unsigned sum, cnt, mine, sp = 0u;
    for (;;) {
        sum = 0u; cnt = 0u; mine = 0u;
#pragma unroll
        for (unsigned j = 0; j < 16; ++j) { const unsigned c = xb_ld(&bar[XB_XCNT(j)]); sum += c; cnt += (c > 0u) ? 1u : 0u; mine = (j == x) ? c : mine; }
        if (sum == G) break;
        __builtin_amdgcn_s_sleep(1);
        if ((++sp & 255u) == 0u) { if (xb_ld(&bar[XB_TMO])) break; if (sp > XB_SPIN_CAP) { atomicAdd(&bar[XB_TMO], 1u); break; } }
    }
    nloc = mine > 0u ? mine : 1u; nx = cnt > 0u ? cnt : 1u;
}

__device__ __forceinline__ void xcd_barrier(const XcdBarrier& b) {
    asm volatile("s_waitcnt vmcnt(0)" ::: "memory");
    __syncthreads();
    if (threadIdx.x == 0) {
        unsigned* bar = b.bar;
        __builtin_amdgcn_s_waitcnt(0);
        unsigned nloc = b.st[0], nx = b.st[1];
        if (nloc == 0u) { xcd_barrier_complete(bar, b.x, nloc, nx); b.st[0] = nloc; b.st[1] = nx; }
        const unsigned old = xb_add(&bar[XB_XSUB(b.x)], 1u);
        const unsigned gen = old / nloc;
        if (old + 1u == (gen + 1u) * nloc) {
            __builtin_amdgcn_fence(__ATOMIC_RELEASE, "agent");
            asm volatile("s_waitcnt vmcnt(0)" ::: "memory");
            const unsigned og = xb_add(&bar[XB_TOP], 1u);
            const unsigned tg = og / nx;
            if (og + 1u == (tg + 1u) * nx) xb_add(&bar[XB_TOPGEN], 1u);
            else XB_SPIN(xb_ld(&bar[XB_TOPGEN]) == tg, bar);
            __builtin_amdgcn_fence(__ATOMIC_ACQUIRE, "agent");
            xb_add(&bar[XB_XGEN(b.x)], 1u);
            asm volatile("s_waitcnt vmcnt(0)" ::: "memory");
        } else {
            XB_SPIN(xb_ld(&bar[XB_XGEN(b.x)]) == gen, bar);
            __builtin_amdgcn_fence(__ATOMIC_ACQUIRE, "agent");
            asm volatile("s_waitcnt vmcnt(0)" ::: "memory");
        }
    }
    __syncthreads();
}

#ifndef USE_XB
#define USE_XB 1
#endif
#ifndef REP_MASK
#define REP_MASK 0u
#endif
#ifndef EXTRA_SYNCS
#define EXTRA_SYNCS 0
#endif
#ifndef PROBE_LN
#define PROBE_LN 0
#endif
#ifndef PROBE_GS
#define PROBE_GS 0
#endif
#ifndef PROBE_W2
#define PROBE_W2 0
#endif
#ifndef ONLY_PH
#define ONLY_PH -1
#endif
#define PHSEL(n) (ONLY_PH < 0 || ONLY_PH == (n))
__global__ void __launch_bounds__(512, 2) mega(Params p) {
    extern __shared__ __attribute__((aligned(16))) unsigned char shm[];
    cg::grid_group grid = cg::this_grid();
    const int wg = blockIdx.x, nwg = gridDim.x;
    unsigned char* ws = p.ws;
    const float* MOD = (const float*)(ws + WS_MOD);
    bf16_t* Hb = (bf16_t*)(ws + WS_H);
    bf16_t* BIG = (bf16_t*)(ws + WS_BIG);
    LAS unsigned char* lds = (LAS unsigned char*)shm;
    volatile LAS unsigned* xst = (volatile LAS unsigned*)(lds + 131072);
    if (threadIdx.x == 0) { xst[0] = 0u; xst[1] = 0u; }
    __syncthreads();
    const XcdBarrier xb = xcd_barrier_post((unsigned*)(ws + WS_CTL), xst);
#define GSYNC() do { if (USE_XB) xcd_barrier(xb); else grid.sync(); } while (0)
#define PH(n) if (PHSEL(n))
    if (p.ph_lo == 0x7fffffff) grid.sync();
    PH(0) phase_prep(p, shm, wg, nwg, 0);
    GSYNC();
    PH(1) { pg8::Gemm g{(const bf16_t*)(ws + WS_CMAT), BIG, CPAD, MODN, D, D}; pg8::StaticOrder S; S.init(CPAD, MODN, nwg, wg);
            pg8::EpiF32 E{(float*)(ws + WS_MOD), MODN, p.in[8]}; pg8::gemm_phase(lds, g, S, E); }
    PH(0) if (wg >= 48) phase_prep(p, shm, wg - 48, nwg - 48, 1);
    GSYNC();
    PH(2) phase_mod0(p, wg, nwg);
    GSYNC();
#pragma unroll 1
    for (int l = 0; l < 2; ++l) {
        PH(3) { const int N = l ? GLANP : NQKV;
                pg8::Gemm g{Hb, (const bf16_t*)(ws + (l ? WS_WT_GIN : WS_WT_AIN)), R, N, D, D}; pg8::StaticOrder S; S.init(R, N, nwg, wg);
                pg8::EpiBf16 E{BIG, N, 0}; pg8::gemm_phase(lds, g, S, E); }
        PH(0) if (l == 0 && wg >= 140) phase_prep(p, shm, wg - 140, nwg - 140, 2);
        GSYNC();
        if (l == 0) {
            PH(4) for (int u = wg; u < 512 + 512; u += nwg) { if (u < 512) attn_prompt_unit(p, shm, u); else attn_sample_unit(p, shm, u - 512); }
            GSYNC();
        } else {
            PH(11) for (int u = wg; u < 256; u += nwg) gla_g1_item(p, shm, u);
            GSYNC();
            PH(12) { gla_g2(p, wg, nwg); for (int u = wg; u < 512; u += nwg) gla_sample_item(p, shm, u); }
            GSYNC();
            PH(13) for (int u = wg; u < 256; u += nwg) gla_g3_item(p, shm, u);
            GSYNC();
        }
        PH(5) { pg8::Gemm g{Hb, (const bf16_t*)(ws + (l ? WS_WT_GOUT : WS_WT_AOUT)), R, D, D, 256}; pg8::SplitOrder S; S.init(D, 4, nwg, wg);
                pg8::EpiResid E{(bf16_t*)(ws + WS_YB), l ? nullptr : p.in[0], MOD + (2 * l) * 3072 + 2048, (float*)(ws + WS_PART), p.in[9] + 1 * D, p.in[10] + 1 * D, (const float*)(ws + WS_STATS)}; pg8::gemm_phase(lds, g, S, E); }
        GSYNC();
        PH(6) phase_ln(p, 2 * l, 2 * l + 1, 4, 2 * l, wg, nwg);
        GSYNC();
        PH(7) { pg8::Gemm g{Hb, (const bf16_t*)(ws + WS_WT_W1) + (size_t)l * DFF * D, R, DFF, D, D}; pg8::StaticOrder S; S.init(R, DFF, nwg, wg);
                pg8::EpiBf16 E{BIG, DFF, 1}; pg8::gemm_phase(lds, g, S, E); }
        GSYNC();
        PH(8) { pg8::Gemm g{BIG, (const bf16_t*)(ws + WS_WT_W2) + (size_t)l * D * DFF, R, D, DFF, 256}; pg8::SplitOrder S; S.init(D, 16, nwg, wg);
                pg8::EpiResid E{(bf16_t*)(ws + WS_YB), nullptr, MOD + (l * 2 + 1) * 3072 + 2048, (float*)(ws + WS_PART), p.in[9] + (l * 2) * D, p.in[10] + (l * 2) * D, (const float*)(ws + WS_STATS)}; pg8::gemm_phase(lds, g, S, E); }
        GSYNC();
        PH(9) phase_ln(p, 2 * l + 1, l ? -1 : 2, 16, 2 * l + 1, wg, nwg);
        if (l == 0) GSYNC();
    }
}

#ifndef MK_ONE_LAUNCH
#define MK_ONE_LAUNCH 1
#endif

extern "C" void kernel_launch(void* const* d_in, const int* in_sizes, int n_in, void* d_out, int out_size, void* d_ws, size_t ws_size, hipStream_t stream) {
    static int grid = 0;
    if (grid == 0) {
        if (n_in != 21 || ws_size < WS_END) { fprintf(stderr, "kernel_launch: unexpected n_in %d or ws_size %zu (< %zu)\n", n_in, ws_size, (size_t)WS_END); grid = -1; return; }
        int dev = 0, cus = 0, per_cu = 0;
        hipGetDevice(&dev);
        hipDeviceGetAttribute(&cus, hipDeviceAttributeMultiprocessorCount, dev);
        if (hipFuncSetAttribute((const void*)mega, hipFuncAttributeMaxDynamicSharedMemorySize, LDS_BYTES) != hipSuccess) { fprintf(stderr, "kernel_launch: hipFuncSetAttribute failed\n"); grid = -1; return; }
        if (hipOccupancyMaxActiveBlocksPerMultiprocessor(&per_cu, (const void*)mega, 512, LDS_BYTES) != hipSuccess || per_cu < 1) { fprintf(stderr, "kernel_launch: occupancy query failed (%d)\n", per_cu); per_cu = 1; }
        (void)hipGetLastError();
        grid = cus * per_cu;
    }
    if (grid < 0) return;
    if (hipMemsetAsync((char*)d_ws + WS_CTL, 0, CTL_BYTES, stream) != hipSuccess) { fprintf(stderr, "kernel_launch: memset failed\n"); return; }
    Params p{};
    for (int i = 0; i < 21; ++i) p.in[i] = (const float*)d_in[i];
    p.out = (float*)d_out; p.ws = (unsigned char*)d_ws;
#if MK_ONE_LAUNCH
    p.ph_lo = 0; p.ph_hi = NPH;
    void* args[] = {&p};
    hipError_t e = hipLaunchCooperativeKernel((const void*)mega, dim3(grid), dim3(512), args, LDS_BYTES, stream);
    if (e != hipSuccess) fprintf(stderr, "cooperative launch failed: %s (grid %d)\n", hipGetErrorString(e), grid);
#else
    for (int ph = 0; ph < NPH; ++ph) {
        p.ph_lo = ph; p.ph_hi = ph + 1;
        hipLaunchKernelGGL(mega, dim3(grid), dim3(512), LDS_BYTES, stream, p);
    }
#endif
}
```

```cpp
#include <hip/hip_runtime.h>
#include <hip/hip_cooperative_groups.h>
#include <cstdio>
#include <cstdint>
namespace cg = cooperative_groups;

#define LAS __attribute__((address_space(3)))
typedef unsigned short bf16_t;
typedef short bf16x8 __attribute__((ext_vector_type(8)));
typedef float f32x4 __attribute__((ext_vector_type(4)));
typedef unsigned u32x4 __attribute__((ext_vector_type(4)));
typedef unsigned u32x2 __attribute__((ext_vector_type(2)));

constexpr int D = 1024, LP = 16384, NSEQ = 128, LS = 4, RS = NSEQ * LS, R = LP + RS;
constexpr int CPAD = 256, MODN = 12288;
constexpr int NQKV = 1536, GLAN = 3088, GLANP = 3328, DFF = 4096;
constexpr float ALPHA = 1.4142135623730951f;
constexpr float LN_EPS = 1e-5f;
constexpr int NPH = 19;
constexpr int LDS_BYTES = 131072 + 1024;

constexpr size_t O_Y = 0, O_KP = 17301504, O_VP = 17334272, O_GP = 17367040, O_KS = 17498112, O_VS = 21692416, O_GS = 25886720;
constexpr size_t WS_WT_AIN = 0;
constexpr size_t WS_WT_AOUT = WS_WT_AIN + (size_t)NQKV * D * 2;
constexpr size_t WS_WT_GIN = WS_WT_AOUT + (size_t)D * D * 2;
constexpr size_t WS_WT_GOUT = WS_WT_GIN + (size_t)GLANP * D * 2;
constexpr size_t WS_WT_W1 = WS_WT_GOUT + (size_t)D * D * 2;
constexpr size_t WS_WT_W2 = WS_WT_W1 + (size_t)2 * DFF * D * 2;
constexpr size_t WS_MOD = WS_WT_W2 + (size_t)2 * DFF * D * 2;
constexpr size_t WS_CMAT = WS_MOD + (size_t)CPAD * MODN * 4;
constexpr size_t WS_H = WS_CMAT + (size_t)CPAD * D * 2;
constexpr size_t WS_GST = WS_H + (size_t)R * D * 2;
constexpr size_t WS_PART = WS_GST;
constexpr size_t WS_GDEC = WS_GST + (size_t)64 * 4 * 256 * 128 * 4;
constexpr size_t WS_BIG = WS_GDEC + (size_t)64 * 4 * 128 * 4;
constexpr size_t WS_CTL = WS_BIG + (size_t)R * DFF * 2;
constexpr size_t CTL_BYTES = 16384;
constexpr size_t WS_STATS = WS_CTL + CTL_BYTES;
constexpr size_t WS_YB = WS_STATS + (size_t)R * 8;
constexpr size_t WS_END = WS_YB + (size_t)R * D * 2;

struct Params {
    const float* in[21];
    float* out;
    unsigned char* ws;
    int ph_lo, ph_hi;
};

typedef __bf16 bf16x2_t __attribute__((ext_vector_type(2)));
typedef float f32x2_t __attribute__((ext_vector_type(2)));
__device__ __forceinline__ unsigned cvt_pk_bf16(float lo, float hi) { const f32x2_t v = {lo, hi}; const bf16x2_t r = __builtin_convertvector(v, bf16x2_t); return __builtin_bit_cast(unsigned, r); }
__device__ __forceinline__ float bf2f(bf16_t b) { return __builtin_bit_cast(float, (unsigned)b << 16); }
__device__ __forceinline__ float bflo(unsigned u) { return __builtin_bit_cast(float, u << 16); }
__device__ __forceinline__ float bfhi(unsigned u) { return __builtin_bit_cast(float, u & 0xffff0000u); }
__device__ __forceinline__ int tidx() { int t = threadIdx.x; asm volatile("" : "+v"(t)); return t; }
typedef short s16x4 __attribute__((ext_vector_type(4)));
__device__ __forceinline__ bf16x8 tr_pair(const bf16_t* p0, const bf16_t* p1) {
    const s16x4 a = __builtin_amdgcn_ds_read_tr16_b64_v4i16((LAS s16x4*)p0), b = __builtin_amdgcn_ds_read_tr16_b64_v4i16((LAS s16x4*)p1);
    return (bf16x8){a[0], a[1], a[2], a[3], b[0], b[1], b[2], b[3]};
}
__device__ __forceinline__ float siluf(float x) { return x / (1.f + __expf(-x)); }
__device__ __forceinline__ float wave_sum(float v) {
#pragma unroll
    for (int o = 32; o > 0; o >>= 1) v += __shfl_xor(v, o, 64);
    return v;
}
__device__ __forceinline__ float wave_max(float v) {
#pragma unroll
    for (int o = 32; o > 0; o >>= 1) v = fmaxf(v, __shfl_xor(v, o, 64));
    return v;
}

namespace pg8 {
constexpr int BM = 256, BK = 64, HALF = 128, HTB = HALF * BK * 2, STAGE_BYTES = 8 * HTB, NXCD = 8, WGM = 8;
__host__ __device__ __forceinline__ int lds_byte(int r, int c) { const int st = (r >> 4) * 2 + (c >> 5), rr = r & 15, cc = c & 31, ob = rr * 64 + cc * 2; return st * 1024 + (ob ^ (((ob >> 9) & 1) << 5)); }
__host__ __device__ __forceinline__ void stage_rc(int b, int& Rr, int& C) { const int st = b / 1024, sb = b % 1024, swz = sb ^ (((sb >> 9) & 1) << 5); Rr = (st >> 1) * 16 + swz / 64; C = (st & 1) * 32 + (swz % 64) / 2; }
__host__ __device__ __forceinline__ int perm32(int rho) { const int n = rho >> 4, i = rho & 15; return 8 * (i >> 2) + 4 * n + (i & 3); }
struct Unit { int pm, pn, ks; };
struct Gemm { const bf16_t* A; const bf16_t* Bt; int M, N, K, Ksp; };
struct StaticOrder {
    int nM, nN, nwg, G, c;
    __host__ __device__ void init(int M, int N, int G_, int c_) { nM = M / BM; nN = N / BM; nwg = nM * nN; G = G_; c = c_; }
    __host__ __device__ bool next(int i, Unit& u) const {
        const long L = (long)i * G + c; if (L >= nwg) return false;
        int wgid = (int)L; { const int q = nwg / NXCD, r = nwg % NXCD, xcd = wgid % NXCD, off = wgid / NXCD; wgid = (xcd < r ? xcd * (q + 1) : r * (q + 1) + (xcd - r) * q) + off; }
        const int nig = WGM * nN, gid = wgid / nig, fm = gid * WGM, gsz = (nM - fm) < WGM ? (nM - fm) : WGM;
        u.pm = fm + ((wgid % nig) % gsz); u.pn = (wgid % nig) / gsz; u.ks = -1; return true;
    }
    __host__ __device__ int nextp(int i) const { Unit u; return next(i, u) ? (u.pm | (u.pn << 8)) : -1; }
    __device__ __forceinline__ void a_ready(const Unit&) const {}
    __device__ __forceinline__ void done(const Unit&) const {}
};
struct SplitOrder {
    StaticOrder P; int nN, nsplit, nsu;
    __host__ __device__ void init(int N, int nsplit_, int G_, int c_) { P.init(LP, N, G_, c_); nN = N / BM; nsplit = nsplit_; nsu = 2 * nN * nsplit; }
    __host__ __device__ bool next(int i, Unit& u) const {
        const long L = (long)i * P.G + P.c;
        if (L < P.nwg) return P.next(i, u);
        const int j = (int)(L - P.nwg); if (j >= nsu) return false;
        const int tile = j / nsplit; u.ks = j - tile * nsplit; u.pm = LP / BM + (tile & 1); u.pn = tile >> 1; return true;
    }
    __host__ __device__ int nextp(int i) const {
        const long L = (long)i * P.G + P.c;
        if (L < P.nwg) return P.nextp(i);
        const int j = (int)(L - P.nwg); if (j >= nsu) return -1;
        const int tile = j / nsplit;
        return (LP / BM + (tile & 1)) | ((tile >> 1) << 8) | ((j - tile * nsplit + 1) << 16);
    }
    __device__ __forceinline__ void a_ready(const Unit&) const {}
    __device__ __forceinline__ void done(const Unit&) const {}
};

struct EpiF32 {
    static constexpr bool PERM = false;
    float* C; int ldc; const float* bias;
    __device__ __forceinline__ void operator()(const f32x4 (&acc)[2][2][4][2], const Unit& u, int wr, int wc, int fr, int fq) const {
        const int row0 = u.pm * BM + wr * 64 + fr, col0 = u.pn * BM + wc * 32 + 4 * fq;
        f32x4 bv[2][2];
#pragma unroll
        for (int bj = 0; bj < 2; ++bj)
#pragma unroll
            for (int n = 0; n < 2; ++n) bv[bj][n] = *(const f32x4*)(bias + col0 + bj * HALF + n * 16);
#pragma unroll
        for (int ai = 0; ai < 2; ++ai)
#pragma unroll
            for (int m = 0; m < 4; ++m) { float* rowp = C + (size_t)(row0 + ai * HALF + m * 16) * ldc + col0;
#pragma unroll
                for (int bj = 0; bj < 2; ++bj)
#pragma unroll
                    for (int n = 0; n < 2; ++n) *(f32x4*)(rowp + bj * HALF + n * 16) = acc[ai][bj][m][n] + bv[bj][n]; }
    }
};
struct EpiBf16 {
    static constexpr bool PERM = true;
    bf16_t* O; int ldc; int act;
    __device__ __forceinline__ void operator()(const f32x4 (&acc)[2][2][4][2], const Unit& u, int wr, int wc, int fr, int fq) const {
        const int row0 = u.pm * BM + wr * 64 + fr, col0 = u.pn * BM + wc * 32 + 8 * fq;
#pragma unroll
        for (int ai = 0; ai < 2; ++ai)
#pragma unroll
            for (int m = 0; m < 4; ++m) { bf16_t* rowp = O + (size_t)(row0 + ai * HALF + m * 16) * ldc + col0;
#pragma unroll
                for (int bj = 0; bj < 2; ++bj) { f32x4 v0 = acc[ai][bj][m][0], v1 = acc[ai][bj][m][1];
                    if (act) {
#pragma unroll
                        for (int e = 0; e < 4; ++e) { float a = fmaxf(v0[e], 0.f), b = fmaxf(v1[e], 0.f); v0[e] = a * a; v1[e] = b * b; } }
                    u32x4 o; o[0] = cvt_pk_bf16(v0[0], v0[1]); o[1] = cvt_pk_bf16(v0[2], v0[3]); o[2] = cvt_pk_bf16(v1[0], v1[1]); o[3] = cvt_pk_bf16(v1[2], v1[3]);
                    *(u32x4*)(rowp + bj * HALF) = o; } }
    }
};
struct EpiResid {
    static constexpr bool PERM = true;
    bf16_t* Yb; const float* Xin; const float* gate; float* part; const float* lg; const float* lb; const float* stats;
    __device__ __forceinline__ void operator()(const f32x4 (&acc)[2][2][4][2], const Unit& u, int wr, int wc, int fr, int fq) const {
        const int row0 = u.pm * BM + wr * 64 + fr, col0 = u.pn * BM + wc * 32 + 8 * fq;
        if (u.ks >= 0) {
            float* pb = part + ((size_t)u.ks * RS + (row0 - LP)) * D + col0;
#pragma unroll
            for (int ai = 0; ai < 2; ++ai)
#pragma unroll
                for (int m = 0; m < 4; ++m)
#pragma unroll
                    for (int bj = 0; bj < 2; ++bj) { float* q = pb + (size_t)(ai * HALF + m * 16) * D + bj * HALF;
                        *(f32x4*)q = acc[ai][bj][m][0]; *(f32x4*)(q + 4) = acc[ai][bj][m][1]; }
            return;
        }
#pragma unroll
        for (int bj = 0; bj < 2; ++bj) {
            const int col = col0 + bj * HALF;
            const f32x4 g0 = *(const f32x4*)(gate + col), g1 = *(const f32x4*)(gate + col + 4);
            f32x4 l0 = (f32x4){1.f, 1.f, 1.f, 1.f}, l1 = l0, b0 = (f32x4){0.f, 0.f, 0.f, 0.f}, b1 = b0;
            if (!Xin) { l0 = *(const f32x4*)(lg + col); l1 = *(const f32x4*)(lg + col + 4); b0 = *(const f32x4*)(lb + col); b1 = *(const f32x4*)(lb + col + 4); }
#pragma unroll
            for (int r8 = 0; r8 < 8; ++r8) {
                const int row = row0 + (r8 >> 2) * HALF + (r8 & 3) * 16;
                bf16_t* yp = Yb + (size_t)row * D + col;
                f32x4 x0, x1;
                if (Xin) { x0 = *(const f32x4*)(Xin + (size_t)row * D + col); x1 = *(const f32x4*)(Xin + (size_t)row * D + col + 4); }
                else { const u32x4 yb = *(const u32x4*)yp; const float2 st = *(const float2*)(stats + 2 * (size_t)row);
                    x0 = (f32x4){bflo(yb[0]), bfhi(yb[0]), bflo(yb[1]), bfhi(yb[1])}; x1 = (f32x4){bflo(yb[2]), bfhi(yb[2]), bflo(yb[3]), bfhi(yb[3])};
                    x0 = (x0 - st.x) * st.y * l0 + b0; x1 = (x1 - st.x) * st.y * l1 + b1; }
                const f32x4 y0 = x0 * ALPHA + g0 * acc[r8 >> 2][bj][r8 & 3][0], y1 = x1 * ALPHA + g1 * acc[r8 >> 2][bj][r8 & 3][1];
                u32x4 o; o[0] = cvt_pk_bf16(y0[0], y0[1]); o[1] = cvt_pk_bf16(y0[2], y0[3]); o[2] = cvt_pk_bf16(y1[0], y1[1]); o[3] = cvt_pk_bf16(y1[2], y1[3]);
                *(u32x4*)yp = o; } }
    }
};

template <class Epi, class Sched>
__device__ __forceinline__ void gemm_phase(LAS unsigned char* lds, const Gemm g, const Sched& S, const Epi& E) {
    const int tid = tidx(), wid = __builtin_amdgcn_readfirstlane(tid >> 6), lane = tid & 63, wr = wid >> 2, wc = wid & 3, fr = lane & 15, fq = lane >> 4;
    const int K = g.K;
    unsigned voffA[2], voffB[2];
#pragma unroll
    for (int i = 0; i < 2; ++i) { int Rr, C; stage_rc(tid * 16 + i * 8192, Rr, C); const int Rb = Epi::PERM ? ((Rr & ~31) + perm32(Rr & 31)) : Rr;
        voffA[i] = (unsigned)(Rr * K + C) * 2u; voffB[i] = (unsigned)(Rb * K + C) * 2u; }
    const size_t kstep = (size_t)(BK * 2);
    const size_t hstep = (size_t)HALF * K * 2;
    const size_t tstep = 2 * hstep;
    const unsigned ldsw = (unsigned)wid * 1024u;
    const int aoff = lds_byte(wr * 64 + fr, fq * 8), boff = lds_byte(wc * 32 + fr, fq * 8);
#define PG8_SA(b, h) (((b) * 2 + (h)) * HTB)
#define PG8_SB(b, h) ((4 + (b) * 2 + (h)) * HTB)
#define PG8_STAGE(bufoff, gbase, voff) do { _Pragma("unroll") for (int _i = 0; _i < 2; ++_i) \
        __builtin_amdgcn_global_load_lds((const unsigned*)((const char*)(gbase) + (voff)[_i]), (LAS unsigned*)(lds + (bufoff) + ldsw + _i * 8192), 16, 0, 0); } while (0)
#define PG8_LDA(dst, b, h) do { _Pragma("unroll") for (int m = 0; m < 4; ++m) _Pragma("unroll") for (int k = 0; k < 2; ++k) dst[m][k] = *(const LAS bf16x8*)(lds + PG8_SA(b, h) + aoff + m * 2048 + k * 1024); } while (0)
#define PG8_LDB(dst, b, h) do { _Pragma("unroll") for (int n = 0; n < 2; ++n) _Pragma("unroll") for (int k = 0; k < 2; ++k) dst[n][k] = *(const LAS bf16x8*)(lds + PG8_SB(b, h) + boff + n * 2048 + k * 1024); } while (0)
#define PG8_MMA(ai, bj, At, Bt) do { __builtin_amdgcn_s_setprio(1); _Pragma("unroll") for (int m = 0; m < 4; ++m) _Pragma("unroll") for (int n = 0; n < 2; ++n) _Pragma("unroll") for (int k = 0; k < 2; ++k) \
        acc[ai][bj][m][n] = __builtin_amdgcn_mfma_f32_16x16x32_bf16(Bt[n][k], At[m][k], acc[ai][bj][m][n], 0, 0, 0); __builtin_amdgcn_s_setprio(0); } while (0)
#define PG8_WAIT_V(n) asm volatile("s_waitcnt vmcnt(" #n ")" ::: "memory")
#define PG8_WAIT_L(n) asm volatile("s_waitcnt lgkmcnt(" #n ")" ::: "memory")
#define PG8_BAR __builtin_amdgcn_s_barrier()
#define PG8_SCHED __builtin_amdgcn_sched_barrier(0)
    Unit cur, nxt; int ui = 0;
    { const int pk = S.nextp(0); if (pk < 0) return; cur.pm = pk & 255; cur.pn = (pk >> 8) & 255; cur.ks = (pk >> 16) - 1; }
    f32x4 acc[2][2][4][2];
#pragma unroll
    for (int a = 0; a < 2; ++a)
#pragma unroll
        for (int b = 0; b < 2; ++b)
#pragma unroll
            for (int m = 0; m < 4; ++m)
#pragma unroll
                for (int n = 0; n < 2; ++n) acc[a][b][m][n] = (f32x4){0.f, 0.f, 0.f, 0.f};
    bf16x8 At[4][2], B0[2][2], B1[2][2];
    const size_t ksb = (size_t)g.Ksp * 2;
    const char* cA = (const char*)g.A + (size_t)cur.pm * tstep + (cur.ks < 0 ? (size_t)0 : cur.ks * ksb); const char* cB = (const char*)g.Bt + (size_t)cur.pn * tstep + (cur.ks < 0 ? (size_t)0 : cur.ks * ksb);
    int nt = (cur.ks < 0 ? K : g.Ksp) / BK;
    S.a_ready(cur);
    PG8_STAGE(PG8_SB(0, 0), cB, voffB); PG8_STAGE(PG8_SA(0, 0), cA, voffA); PG8_STAGE(PG8_SB(0, 1), cB + hstep, voffB); PG8_STAGE(PG8_SA(0, 1), cA + hstep, voffA);
    if (wr == 1) PG8_BAR;
    PG8_WAIT_V(4); PG8_BAR;
    PG8_STAGE(PG8_SB(1, 0), cB + kstep, voffB); PG8_STAGE(PG8_SA(1, 0), cA + kstep, voffA); PG8_STAGE(PG8_SB(1, 1), cB + hstep + kstep, voffB);
    PG8_WAIT_V(6); PG8_BAR;
    for (;;) {
        const int npk = S.nextp(ui + 1); const bool has_next = npk >= 0; nxt.pm = npk & 255; nxt.pn = (npk >> 8) & 255; nxt.ks = (npk >> 16) - 1;
        const size_t nko = (has_next && nxt.ks >= 0) ? nxt.ks * ksb : (size_t)0;
        const char* nA = has_next ? (const char*)g.A + (size_t)nxt.pm * tstep + nko : cA; const char* nB = has_next ? (const char*)g.Bt + (size_t)nxt.pn * tstep + nko : cB;
        for (int t = 0; t < nt; t += 2) {
            const bool last = (t == nt - 2);
            const char* a1 = cA + (size_t)(t + 1) * kstep;
            const char* a2 = last ? nA : cA + (size_t)(t + 2) * kstep; const char* b2 = last ? nB : cB + (size_t)(t + 2) * kstep;
            const char* a3 = a2 + kstep; const char* b3 = b2 + kstep;
            if (last && has_next) S.a_ready(nxt);
            PG8_LDB(B0, 0, 0); PG8_SCHED; PG8_LDA(At, 0, 0); PG8_STAGE(PG8_SA(1, 1), a1 + hstep, voffA);
            PG8_WAIT_L(8); PG8_BAR; PG8_WAIT_L(0); PG8_MMA(0, 0, At, B0); PG8_BAR; PG8_SCHED;
            PG8_LDB(B1, 0, 1); PG8_STAGE(PG8_SB(0, 0), b2, voffB);
            PG8_BAR; PG8_WAIT_L(0); PG8_MMA(0, 1, At, B1); PG8_BAR;
            PG8_LDA(At, 0, 1); PG8_STAGE(PG8_SA(0, 0), a2, voffA);
            PG8_BAR; PG8_WAIT_L(0); PG8_MMA(1, 0, At, B0); PG8_BAR; PG8_SCHED;
            PG8_STAGE(PG8_SB(0, 1), b2 + hstep, voffB);
            PG8_WAIT_V(6); PG8_BAR; PG8_MMA(1, 1, At, B1); PG8_BAR;
            PG8_LDB(B0, 1, 0); PG8_SCHED; PG8_LDA(At, 1, 0); PG8_STAGE(PG8_SA(0, 1), a2 + hstep, voffA);
            PG8_WAIT_L(8); PG8_BAR; PG8_WAIT_L(0); PG8_MMA(0, 0, At, B0); PG8_BAR; PG8_SCHED;
            PG8_LDB(B1, 1, 1); PG8_STAGE(PG8_SB(1, 0), b3, voffB);
            PG8_BAR; PG8_WAIT_L(0); PG8_MMA(0, 1, At, B1); PG8_BAR;
            PG8_LDA(At, 1, 1); PG8_STAGE(PG8_SA(1, 0), a3, voffA);
            PG8_BAR; PG8_WAIT_L(0); PG8_MMA(1, 0, At, B0); PG8_BAR; PG8_SCHED;
            PG8_STAGE(PG8_SB(1, 1), b3 + hstep, voffB);
            PG8_WAIT_V(6); PG8_BAR; PG8_MMA(1, 1, At, B1); PG8_BAR;
        }
        E(acc, cur, wr, wc, fr, fq); S.done(cur);
        if (!has_next) break;
#pragma unroll
        for (int a = 0; a < 2; ++a)
#pragma unroll
            for (int b = 0; b < 2; ++b)
#pragma unroll
                for (int m = 0; m < 4; ++m)
#pragma unroll
                    for (int n = 0; n < 2; ++n) acc[a][b][m][n] = (f32x4){0.f, 0.f, 0.f, 0.f};
        cur = nxt; cA = nA; cB = nB; ++ui; nt = (cur.ks < 0 ? K : g.Ksp) / BK;
    }
    PG8_WAIT_V(0);
    if (wr == 0) PG8_BAR;
    PG8_BAR;
#undef PG8_SA
#undef PG8_SB
#undef PG8_STAGE
#undef PG8_LDA
#undef PG8_LDB
#undef PG8_MMA
#undef PG8_WAIT_V
#undef PG8_WAIT_L
#undef PG8_BAR
#undef PG8_SCHED
}
}

__device__ __forceinline__ void transpose_convert(const float* __restrict__ W, bf16_t* __restrict__ Wt, int K, int N, int Npad, float* tile, int wg, int nwg) {
    const int tid = tidx();
    const int tn_n = Npad / 256, tk_n = K / 64, ntl = tn_n * tk_n;
    for (int t = wg; t < ntl; t += nwg) {
        const int tn = t % tn_n, tk = t / tn_n;
        float v[32];
#pragma unroll
        for (int e = 0; e < 32; ++e) { const int idx = e * 512 + tid, r = idx >> 8, c = idx & 255; const int col = tn * 256 + c;
            v[e] = col < N ? W[(size_t)(tk * 64 + r) * N + col] : 0.f; }
#pragma unroll
        for (int e = 0; e < 32; ++e) { const int idx = e * 512 + tid, r = idx >> 8, c = idx & 255; tile[r * 257 + c] = v[e]; }
        __syncthreads();
#pragma unroll
        for (int e = 0; e < 4; ++e) { const int ch = e * 512 + tid, n = ch >> 3, kc = ch & 7;
            u32x4 o;
#pragma unroll
            for (int j = 0; j < 4; ++j) o[j] = cvt_pk_bf16(tile[(kc * 8 + 2 * j) * 257 + n], tile[(kc * 8 + 2 * j + 1) * 257 + n]);
            *(u32x4*)(Wt + (size_t)(tn * 256 + n) * K + tk * 64 + kc * 8) = o; }
        __syncthreads();
    }
}

__device__ __forceinline__ void phase_prep(const Params& p, unsigned char* shm, int wg, int nwg, int part) {
    float* tile = (float*)shm;
    unsigned char* ws = p.ws;
    if (part == 0) {
        for (int m = 0; m < 4; ++m)
            transpose_convert(p.in[7] + (size_t)m * D * 3072, (bf16_t*)(ws + WS_BIG) + (size_t)m * 3072 * D, D, 3072, 3072, tile, wg, nwg);
        transpose_convert(p.in[11], (bf16_t*)(ws + WS_WT_AIN), D, NQKV, NQKV, tile, wg, nwg);
        transpose_convert(p.in[12], (bf16_t*)(ws + WS_WT_AOUT), D, D, D, tile, wg, nwg);
        bf16_t* cm = (bf16_t*)(ws + WS_CMAT);
        for (int idx = wg * 512 + tidx(); idx < CPAD * D; idx += nwg * 512) {
            const int r = idx >> 10, c = idx & 1023;
            float v = 0.f;
            if (r == 0) v = siluf(p.in[5][c]); else if (r <= NSEQ) v = siluf(p.in[6][(size_t)(r - 1) * D + c]);
            cm[idx] = (bf16_t)(cvt_pk_bf16(v, 0.f) & 0xffffu);
        }
    } else if (part == 1) {
        for (int l = 0; l < 2; ++l) {
            transpose_convert(p.in[19] + (size_t)l * D * DFF, (bf16_t*)(ws + WS_WT_W1) + (size_t)l * DFF * D, D, DFF, DFF, tile, wg, nwg);
            transpose_convert(p.in[20] + (size_t)l * DFF * D, (bf16_t*)(ws + WS_WT_W2) + (size_t)l * D * DFF, DFF, D, D, tile, wg, nwg);
        }
    } else {
        transpose_convert(p.in[14], (bf16_t*)(ws + WS_WT_GIN), D, GLAN, GLANP, tile, wg, nwg);
        transpose_convert(p.in[18], (bf16_t*)(ws + WS_WT_GOUT), D, D, D, tile, wg, nwg);
    }
}

__device__ __forceinline__ int crow_of(int row) { return row < LP ? 0 : 1 + ((row - LP) >> 2); }

__device__ __forceinline__ void phase_mod0(const Params& p, int wg, int nwg) {
    const int tid = tidx(), lane = tid & 63, wave = tid >> 6;
    const float* mod = (const float*)(p.ws + WS_MOD);
    bf16_t* H = (bf16_t*)(p.ws + WS_H);
    f32x4 sh0[4], sc0[4];
#pragma unroll
    for (int k = 0; k < 4; ++k) { sh0[k] = *(const f32x4*)(mod + k * 256 + lane * 4); sc0[k] = *(const f32x4*)(mod + 1024 + k * 256 + lane * 4) + 1.f; }
#pragma unroll 2
    for (int row = wg * 8 + wave; row < R; row += nwg * 8) {
        const float* xr = row < LP ? p.in[0] + (size_t)row * D : p.in[1] + (size_t)(row - LP) * D;
        const float* mr = mod + (size_t)crow_of(row) * MODN;
#pragma unroll
        for (int k = 0; k < 4; ++k) { const int col = k * 256 + lane * 4;
            const f32x4 x = *(const f32x4*)(xr + col);
            f32x4 sh = sh0[k], sc = sc0[k];
            if (row >= LP) { sh = *(const f32x4*)(mr + col); sc = *(const f32x4*)(mr + 1024 + col) + 1.f; }
            const f32x4 h = x * sc + sh;
            u32x2 o; o[0] = cvt_pk_bf16(h[0], h[1]); o[1] = cvt_pk_bf16(h[2], h[3]);
            *(u32x2*)(H + (size_t)row * D + col) = o; }
    }
}

__device__ __forceinline__ void phase_ln(const Params& p, int lnidx, int nset, int nsplit, int gset, int wg, int nwg) {
    const int tid = tidx(), lane = tid & 63, wave = tid >> 6;
    const float* mod = (const float*)(p.ws + WS_MOD);
    bf16_t* H = (bf16_t*)(p.ws + WS_H);
    const bf16_t* Yb = (const bf16_t*)(p.ws + WS_YB);
    float* stats = (float*)(p.ws + WS_STATS);
    float* Y = p.out;
    const float* g = p.in[9] + lnidx * D; const float* b = p.in[10] + lnidx * D;
#define COLK(k) ((((k) >> 1) * 512) + lane * 8 + ((k) & 1) * 4)
    f32x4 gv[4], bv[4];
#pragma unroll
    for (int k = 0; k < 4; ++k) { gv[k] = *(const f32x4*)(g + COLK(k)); bv[k] = *(const f32x4*)(b + COLK(k)); }
    f32x4 gm[4], bm[4];
#pragma unroll
    for (int k = 0; k < 4; ++k) { gm[k] = gv[k]; bm[k] = bv[k];
        if (nset >= 0) { const f32x4 sh = *(const f32x4*)(mod + nset * 3072 + COLK(k)), sc = *(const f32x4*)(mod + nset * 3072 + 1024 + COLK(k)) + 1.f;
            gm[k] = gv[k] * sc; bm[k] = bv[k] * sc + sh; } }
    const int rstep = nwg * 8;
    u32x4 nv[2];
    { const int row0 = wg * 8 + wave;
      nv[0] = *(const u32x4*)(Yb + (size_t)row0 * D + lane * 8); nv[1] = *(const u32x4*)(Yb + (size_t)row0 * D + 512 + lane * 8); }
    for (int row = wg * 8 + wave; row < R; row += rstep) {
        float* yr = Y + (size_t)row * D;
        f32x4 v[4]; float s = 0.f;
        if (row < LP) {
#pragma unroll
            for (int k2 = 0; k2 < 2; ++k2) { v[2 * k2] = (f32x4){bflo(nv[k2][0]), bfhi(nv[k2][0]), bflo(nv[k2][1]), bfhi(nv[k2][1])};
                v[2 * k2 + 1] = (f32x4){bflo(nv[k2][2]), bfhi(nv[k2][2]), bflo(nv[k2][3]), bfhi(nv[k2][3])}; }
            if (row + rstep < LP) { nv[0] = *(const u32x4*)(Yb + (size_t)(row + rstep) * D + lane * 8); nv[1] = *(const u32x4*)(Yb + (size_t)(row + rstep) * D + 512 + lane * 8); }
        } else {
            const float* pr = (const float*)(p.ws + WS_PART) + (size_t)(row - LP) * D;
            const float* gr = mod + (size_t)crow_of(row) * MODN + gset * 3072 + 2048;
            float mu0 = 0.f, rs0 = 1.f;
            if (lnidx > 0) { const float2 st = *(const float2*)(stats + 2 * (size_t)row); mu0 = st.x; rs0 = st.y; }
#pragma unroll
            for (int k = 0; k < 4; ++k) { const int col = COLK(k);
                f32x4 a = *(const f32x4*)(pr + col);
#pragma unroll 3
                for (int sp = 1; sp < nsplit; ++sp) a = a + *(const f32x4*)(pr + (size_t)sp * RS * D + col);
                f32x4 x;
                if (lnidx == 0) x = *(const f32x4*)(p.in[1] + (size_t)(row - LP) * D + col);
                else x = (*(const f32x4*)(yr + col) - mu0) * rs0 * *(const f32x4*)(g - D + col) + *(const f32x4*)(b - D + col);
                v[k] = x * ALPHA + *(const f32x4*)(gr + col) * a;
                if (nset >= 0) *(f32x4*)(yr + col) = v[k]; }
        }
#pragma unroll
        for (int k = 0; k < 4; ++k) s += v[k][0] + v[k][1] + v[k][2] + v[k][3];
        const float mu = wave_sum(s) * (1.f / D);
        float q = 0.f;
#pragma unroll
        for (int k = 0; k < 4; ++k) { const f32x4 d = v[k] - mu; q += d[0] * d[0] + d[1] * d[1] + d[2] * d[2] + d[3] * d[3]; }
        const float rstd = rsqrtf(wave_sum(q) * (1.f / D) + LN_EPS);
        if (nset >= 0 && lane == 0) *(float2*)(stats + 2 * (size_t)row) = make_float2(mu, rstd);
        const float* mr = mod + (size_t)crow_of(row) * MODN + (nset >= 0 ? nset * 3072 : 0);
        if (nset < 0) {
#pragma unroll
            for (int k = 0; k < 4; ++k) *(f32x4*)(yr + COLK(k)) = (v[k] - mu) * rstd * gv[k] + bv[k];
        } else {
            f32x4 h[4];
#pragma unroll
            for (int k = 0; k < 4; ++k) { const int col = COLK(k);
                if (row < LP) h[k] = (v[k] - mu) * rstd * gm[k] + bm[k];
                else { const f32x4 x = (v[k] - mu) * rstd * gv[k] + bv[k]; const f32x4 sh = *(const f32x4*)(mr + col), sc = *(const f32x4*)(mr + 1024 + col); h[k] = x * (sc + 1.f) + sh; } }
#pragma unroll
            for (int k2 = 0; k2 < 2; ++k2) { u32x4 o; o[0] = cvt_pk_bf16(h[2 * k2][0], h[2 * k2][1]); o[1] = cvt_pk_bf16(h[2 * k2][2], h[2 * k2][3]);
                o[2] = cvt_pk_bf16(h[2 * k2 + 1][0], h[2 * k2 + 1][1]); o[3] = cvt_pk_bf16(h[2 * k2 + 1][2], h[2 * k2 + 1][3]);
                *(u32x4*)(H + (size_t)row * D + k2 * 512 + lane * 8) = o; }
        }
    }
#undef COLK
}

__device__ __forceinline__ void attn_prompt_unit(const Params& p, unsigned char* shm, int unit) {
    const int tid = tidx(), lane = tid & 63, w = tid >> 6, c = lane & 15, q = lane >> 4;
    const int nb = unit >> 2, hk = unit & 3;
    const bf16_t* QKV = (const bf16_t*)(p.ws + WS_BIG);
    bf16_t* O = (bf16_t*)(p.ws + WS_H);
    bf16_t* Ks = (bf16_t*)shm;
    bf16_t* Vs = (bf16_t*)(shm + 36864);
    const int rbase = nb * 128 - 128;
#pragma unroll
    for (int i = 0; i < 4; ++i) { const int ch = tid + i * 512, s = ch >> 3, cc = ch & 7; const int grow = rbase + s;
        u32x4 v = (u32x4){0u, 0u, 0u, 0u};
        if (grow >= 0) v = *(const u32x4*)(QKV + (size_t)grow * NQKV + 1024 + hk * 64 + cc * 8);
        *(u32x4*)(Ks + s * 72 + cc * 8) = v; }
#pragma unroll
    for (int i = 0; i < 4; ++i) { const int ch = tid + i * 512, sr = ch >> 3, cc = ch & 7; const int grow = rbase + sr;
        u32x4 v = (u32x4){0u, 0u, 0u, 0u};
        if (grow >= 0) v = *(const u32x4*)(QKV + (size_t)grow * NQKV + 1280 + hk * 64 + cc * 8);
        *(u32x4*)(Vs + sr * 72 + cc * 8) = v; }
    __syncthreads();
    if (nb == 127) {
        float* ok = p.out + O_KP; float* ov = p.out + O_VP;
#pragma unroll
        for (int e = 0; e < 2; ++e) { const int ch = tid + e * 512, sr = ch >> 3, cc = ch & 7;
            const u32x4 kr = *(const u32x4*)(Ks + (128 + sr) * 72 + cc * 8), vr = *(const u32x4*)(Vs + (128 + sr) * 72 + cc * 8);
            float* kd = ok + (sr * 4 + hk) * 64 + cc * 8; float* vd = ov + (sr * 4 + hk) * 64 + cc * 8;
            *(f32x4*)kd = (f32x4){bflo(kr[0]), bfhi(kr[0]), bflo(kr[1]), bfhi(kr[1])}; *(f32x4*)(kd + 4) = (f32x4){bflo(kr[2]), bfhi(kr[2]), bflo(kr[3]), bfhi(kr[3])};
            *(f32x4*)vd = (f32x4){bflo(vr[0]), bfhi(vr[0]), bflo(vr[1]), bfhi(vr[1])}; *(f32x4*)(vd + 4) = (f32x4){bflo(vr[2]), bfhi(vr[2]), bflo(vr[3]), bfhi(vr[3])}; }
    }
    bf16x8 qn[2];
#pragma unroll
    for (int kk = 0; kk < 2; ++kk) qn[kk] = *(const bf16x8*)(QKV + (size_t)(nb * 128 + (w & 3) * 32 + c) * NQKV + (hk * 4 + (w >> 2)) * 64 + kk * 32 + q * 8);
#pragma unroll 1
    for (int it = 0; it < 4; ++it) {
        const int task = w + 8 * (it >> 1), tt = it & 1;
        const int hq = hk * 4 + (task >> 2), w0 = (task & 3) * 32;
        const float slope = exp2f(-0.5f * (float)(hq + 1));
        const float sink = p.in[13][hq];
        bf16x8 qf[2];
#pragma unroll
        for (int kk = 0; kk < 2; ++kk) qf[kk] = qn[kk];
        { const int it2 = it < 3 ? it + 1 : 3, task2 = w + 8 * (it2 >> 1), tt2 = it2 & 1, hq2 = hk * 4 + (task2 >> 2), w02 = (task2 & 3) * 32;
#pragma unroll
          for (int kk = 0; kk < 2; ++kk) qn[kk] = *(const bf16x8*)(QKV + (size_t)(nb * 128 + w02 + tt2 * 16 + c) * NQKV + hq2 * 64 + kk * 32 + q * 8); }
        const int kb = w0 + 16 * tt;
        f32x4 sc[9];
#pragma unroll
        for (int x = 0; x < 9; ++x) {
            sc[x] = (f32x4){0.f, 0.f, 0.f, 0.f};
#pragma unroll
            for (int kk = 0; kk < 2; ++kk) {
                const bf16x8 kf = *(const bf16x8*)(Ks + (kb + x * 16 + c) * 72 + kk * 32 + q * 8);
                sc[x] = __builtin_amdgcn_mfma_f32_16x16x32_bf16(kf, qf[kk], sc[x], 0, 0, 0);
            }
        }
        const int hi = c + 128 - 4 * q;
        int lo = hi - 128; if (nb == 0) lo = max(lo, 128 - kb - 4 * q);
        const unsigned span = (unsigned)(hi - lo);
        const float c0 = -slope * (float)hi;
        float mx = sink;
#pragma unroll
        for (int x = 0; x < 9; ++x)
#pragma unroll
            for (int e = 0; e < 4; ++e) {
                const int k = 16 * x + e;
                const float bias = __builtin_fmaf(slope, (float)k, c0);
                const float v = ((unsigned)(k - lo) <= span) ? __builtin_fmaf(sc[x][e], 0.125f, bias) : -INFINITY;
                sc[x][e] = v; mx = fmaxf(mx, v);
            }
        mx = fmaxf(mx, __shfl_xor(mx, 16, 64)); mx = fmaxf(mx, __shfl_xor(mx, 32, 64));
        float ssum = 0.f;
#pragma unroll
        for (int x = 0; x < 9; ++x)
#pragma unroll
            for (int e = 0; e < 4; ++e) { const float pv = __expf(sc[x][e] - mx); sc[x][e] = pv; ssum += pv; }
        ssum += __shfl_xor(ssum, 16, 64); ssum += __shfl_xor(ssum, 32, 64);
        const float linv = 1.f / (ssum + __expf(sink - mx));
        f32x4 o[4];
#pragma unroll
        for (int dt = 0; dt < 4; ++dt) o[dt] = (f32x4){0.f, 0.f, 0.f, 0.f};
#pragma unroll
        for (int pp = 0; pp < 5; ++pp) {
            u32x4 pu; pu[0] = cvt_pk_bf16(sc[2 * pp][0], sc[2 * pp][1]); pu[1] = cvt_pk_bf16(sc[2 * pp][2], sc[2 * pp][3]);
            if (pp < 4) { pu[2] = cvt_pk_bf16(sc[2 * pp + 1][0], sc[2 * pp + 1][1]); pu[3] = cvt_pk_bf16(sc[2 * pp + 1][2], sc[2 * pp + 1][3]); }
            else { pu[2] = 0u; pu[3] = 0u; }
            const bf16x8 pf = __builtin_bit_cast(bf16x8, pu);
#pragma unroll
            for (int dt = 0; dt < 4; ++dt) {
                const bf16_t* vp = Vs + (kb + 32 * pp + 4 * q + (c >> 2)) * 72 + dt * 16 + 4 * (c & 3);
                const bf16x8 vf = tr_pair(vp, pp < 4 ? vp + 16 * 72 : vp);
                o[dt] = __builtin_amdgcn_mfma_f32_16x16x32_bf16(vf, pf, o[dt], 0, 0, 0);
            }
        }
#pragma unroll
        for (int dt = 0; dt < 4; ++dt) {
            const f32x4 v = o[dt] * linv;
            u32x2 u; u[0] = cvt_pk_bf16(v[0], v[1]); u[1] = cvt_pk_bf16(v[2], v[3]);
            *(u32x2*)(O + (size_t)(nb * 128 + w0 + tt * 16 + c) * D + hq * 64 + dt * 16 + q * 4) = u;
        }
    }
    __syncthreads();
}

__device__ __forceinline__ void attn_sample_pair(const Params& p, unsigned char* shm, int pair) {
    const int tid = tidx(), lane = tid & 63, w = tid >> 6, c = lane & 15, q = lane >> 4;
    const int half = w >> 2, lt = tid & 255, unit = pair * 2 + half;
    const int b = unit >> 2, hk = unit & 3;
    const bf16_t* QKV = (const bf16_t*)(p.ws + WS_BIG);
    bf16_t* O = (bf16_t*)(p.ws + WS_H);
    bf16_t* Ks = (bf16_t*)(shm + half * 46080);
    bf16_t* Vs = Ks + 160 * 72;
    const float* ck = p.in[2]; const float* cv = p.in[3];
    float* ok = p.out + O_KS; float* ov = p.out + O_VS;
    { f32x4 kq[8], vq[8];
#pragma unroll
      for (int e = 0; e < 8; ++e) { const int ch = lt + e * 256, j = ch >> 4, c4 = (ch & 15) * 4; const size_t src = ((size_t)(b * 128 + j) * 4 + hk) * 64 + c4;
          kq[e] = *(const f32x4*)(ck + src); vq[e] = *(const f32x4*)(cv + src); }
#pragma unroll
      for (int e = 0; e < 8; ++e) { const int ch = lt + e * 256, j = ch >> 4, c4 = (ch & 15) * 4;
          u32x2 kb, vb; kb[0] = cvt_pk_bf16(kq[e][0], kq[e][1]); kb[1] = cvt_pk_bf16(kq[e][2], kq[e][3]); vb[0] = cvt_pk_bf16(vq[e][0], vq[e][1]); vb[1] = cvt_pk_bf16(vq[e][2], vq[e][3]);
          *(u32x2*)(Ks + j * 72 + c4) = kb; *(u32x2*)(Vs + j * 72 + c4) = vb;
          if (j >= 4) { const size_t dst = ((size_t)(b * 128 + j - 4) * 4 + hk) * 64 + c4; *(f32x4*)(ok + dst) = kq[e]; *(f32x4*)(ov + dst) = vq[e]; } } }
    if (lt < 64) {
        const int isv = lt >> 5, t = (lt >> 3) & 3, c8 = (lt & 7) * 8; const size_t row = (size_t)(LP + b * 4 + t);
        const u32x4 raw = *(const u32x4*)(QKV + row * NQKV + 1024 + isv * 256 + hk * 64 + c8);
        *(u32x4*)((isv ? Vs : Ks) + (128 + t) * 72 + c8) = raw;
        float* dst = (isv ? ov : ok) + ((size_t)(b * 128 + 124 + t) * 4 + hk) * 64 + c8;
        *(f32x4*)dst = (f32x4){bflo(raw[0]), bfhi(raw[0]), bflo(raw[1]), bfhi(raw[1])}; *(f32x4*)(dst + 4) = (f32x4){bflo(raw[2]), bfhi(raw[2]), bflo(raw[3]), bfhi(raw[3])};
    } else if (lt < 64 + 28 * 2) {
        const int z = lt - 64, isv = z / 28, r = 132 + z % 28;
        bf16_t* dst = (isv ? Vs : Ks) + r * 72;
#pragma unroll
        for (int x = 0; x < 8; ++x) *(u32x4*)(dst + x * 8) = (u32x4){0u, 0u, 0u, 0u};
    }
    __syncthreads();
    if ((w & 3) == 0) {
        const int hq = hk * 4 + (c >> 2), t = c & 3;
        const float slope = exp2f(-0.5f * (float)(hq + 1));
        const float sink = p.in[13][hq];
        bf16x8 qf[2];
#pragma unroll
        for (int kk = 0; kk < 2; ++kk) qf[kk] = *(const bf16x8*)(QKV + (size_t)(LP + b * 4 + t) * NQKV + hq * 64 + kk * 32 + q * 8);
        f32x4 sc[10];
#pragma unroll
        for (int st = 0; st < 10; ++st) {
            sc[st] = (f32x4){0.f, 0.f, 0.f, 0.f};
#pragma unroll
            for (int kk = 0; kk < 2; ++kk) {
                const bf16x8 kf = *(const bf16x8*)(Ks + (st * 16 + c) * 72 + kk * 32 + q * 8);
                sc[st] = __builtin_amdgcn_mfma_f32_16x16x32_bf16(kf, qf[kk], sc[st], 0, 0, 0);
            }
        }
        float mx = sink;
#pragma unroll
        for (int st = 0; st < 10; ++st)
#pragma unroll
            for (int e = 0; e < 4; ++e) {
                const int dist = t + 128 - (st * 16 + q * 4 + e);
                const float v = (dist >= 0 && dist <= 128) ? sc[st][e] * 0.125f - slope * (float)dist : -INFINITY;
                sc[st][e] = v; mx = fmaxf(mx, v);
            }
        mx = fmaxf(mx, __shfl_xor(mx, 16, 64)); mx = fmaxf(mx, __shfl_xor(mx, 32, 64));
        float ssum = 0.f;
#pragma unroll
        for (int st = 0; st < 10; ++st)
#pragma unroll
            for (int e = 0; e < 4; ++e) { const float pv = __expf(sc[st][e] - mx); sc[st][e] = pv; ssum += pv; }
        ssum += __shfl_xor(ssum, 16, 64); ssum += __shfl_xor(ssum, 32, 64);
        const float linv = 1.f / (ssum + __expf(sink - mx));
        f32x4 o[4];
#pragma unroll
        for (int dt = 0; dt < 4; ++dt) o[dt] = (f32x4){0.f, 0.f, 0.f, 0.f};
#pragma unroll
        for (int pp = 0; pp < 5; ++pp) {
            u32x4 pu; pu[0] = cvt_pk_bf16(sc[2 * pp][0], sc[2 * pp][1]); pu[1] = cvt_pk_bf16(sc[2 * pp][2], sc[2 * pp][3]);
            pu[2] = cvt_pk_bf16(sc[2 * pp + 1][0], sc[2 * pp + 1][1]); pu[3] = cvt_pk_bf16(sc[2 * pp + 1][2], sc[2 * pp + 1][3]);
            const bf16x8 pf = __builtin_bit_cast(bf16x8, pu);
#pragma unroll
            for (int dt = 0; dt < 4; ++dt) {
                const bf16_t* vp = Vs + (32 * pp + 4 * q + (c >> 2)) * 72 + dt * 16 + 4 * (c & 3);
                const bf16x8 vf = tr_pair(vp, vp + 16 * 72);
                o[dt] = __builtin_amdgcn_mfma_f32_16x16x32_bf16(vf, pf, o[dt], 0, 0, 0);
            }
        }
#pragma unroll
        for (int dt = 0; dt < 4; ++dt) {
            const f32x4 v = o[dt] * linv;
            u32x2 u; u[0] = cvt_pk_bf16(v[0], v[1]); u[1] = cvt_pk_bf16(v[2], v[3]);
            *(u32x2*)(O + (size_t)(LP + b * 4 + t) * D + hq * 64 + dt * 16 + q * 4) = u;
        }
    }
    __syncthreads();
}

constexpr int G_QD = 0;
constexpr int G_KD = 17408;
constexpr int G_KDT = 34816;
constexpr int G_VT = 53248;
constexpr int G_AM = 90112;
constexpr int G_GD = 99328;
constexpr int G_EBC = 103424;
constexpr int G_SEG = 103936;
constexpr int G_RED = 105984;

__device__ __forceinline__ float log_sigmoid(float z) { return fminf(z, 0.f) - __logf(1.f + __expf(-fabsf(z))); }

template <bool FULL>
__device__ __forceinline__ float gla_preamble(const bf16_t* PROJ, unsigned char* shm, int r0, int h, const float (&wup)[16], float bg) {
    const int tid = tidx();
    bf16_t* QD = (bf16_t*)(shm + G_QD); bf16_t* KD = (bf16_t*)(shm + G_KD); bf16_t* KDT = (bf16_t*)(shm + G_KDT); bf16_t* VT = (bf16_t*)(shm + G_VT);
    float* GD = (float*)(shm + G_GD); float* EBC = (float*)(shm + G_EBC); float* SEG = (float*)(shm + G_SEG);
#pragma unroll
    for (int e = 0; e < 2; ++e) { const int idx = tid + e * 512, t = idx >> 4, j = idx & 15; GD[idx] = bf2f(PROJ[(size_t)(r0 + t) * GLANP + 3072 + j]); }
    const int i = tid & 127, seg = tid >> 7;
    unsigned short kraw[16], qraw[16];
#pragma unroll
    for (int tt = 0; tt < 16; ++tt) { const size_t rr = (size_t)(r0 + seg * 16 + tt) * GLANP + h * 128 + i; kraw[tt] = PROJ[rr + 512]; if (FULL) qraw[tt] = PROJ[rr]; }
#pragma unroll
    for (int e = 0; e < 4; ++e) { const int ch = tid + e * 512, t = ch >> 5, cc = ch & 31;
        *(u32x4*)(VT + t * 264 + cc * 8) = *(const u32x4*)(PROJ + (size_t)(r0 + t) * GLANP + 1024 + h * 256 + cc * 8); }
    __syncthreads();
    float bl[16]; float run = 0.f;
#pragma unroll
    for (int tt = 0; tt < 16; ++tt) { const int t = seg * 16 + tt; float z = bg;
#pragma unroll
        for (int j = 0; j < 16; ++j) z += GD[t * 16 + j] * wup[j];
        run += log_sigmoid(z) * (1.f / 16.f); bl[tt] = run; }
    SEG[seg * 128 + i] = run;
    __syncthreads();
    float pre = 0.f, tot = 0.f;
#pragma unroll
    for (int s = 0; s < 4; ++s) { const float v = SEG[s * 128 + i]; tot += v; if (s < seg) pre += v; }
    float kdv[16];
#pragma unroll
    for (int tt = 0; tt < 16; ++tt) { const int t = seg * 16 + tt; const float bt = pre + bl[tt];
        const float kv = bf2f(kraw[tt]);
        kdv[tt] = kv * __expf(tot - bt);
        if (FULL) {
            const float qv = bf2f(qraw[tt]) * 0.08838834764831845f;
            QD[t * 136 + i] = (bf16_t)(cvt_pk_bf16(qv * __expf(bt), 0.f) & 0xffffu);
            KD[t * 136 + i] = (bf16_t)(cvt_pk_bf16(kv * __expf(-bt), 0.f) & 0xffffu);
        } }
    { u32x4 v0, v1;
      v0[0] = cvt_pk_bf16(kdv[0], kdv[1]); v0[1] = cvt_pk_bf16(kdv[2], kdv[3]); v0[2] = cvt_pk_bf16(kdv[4], kdv[5]); v0[3] = cvt_pk_bf16(kdv[6], kdv[7]);
      v1[0] = cvt_pk_bf16(kdv[8], kdv[9]); v1[1] = cvt_pk_bf16(kdv[10], kdv[11]); v1[2] = cvt_pk_bf16(kdv[12], kdv[13]); v1[3] = cvt_pk_bf16(kdv[14], kdv[15]);
      *(u32x4*)(KDT + i * 72 + seg * 16) = v0; *(u32x4*)(KDT + i * 72 + seg * 16 + 8) = v1; }
    if (seg == 0) EBC[i] = __expf(tot);
    __syncthreads();
    return tot;
}

__device__ __forceinline__ void gla_state_update(f32x4 (&S)[8][2], unsigned char* shm, int w, int c, int q) {
    const bf16_t* KDT = (const bf16_t*)(shm + G_KDT); const bf16_t* VT = (const bf16_t*)(shm + G_VT); const float* EBC = (const float*)(shm + G_EBC);
#pragma unroll
    for (int ib = 0; ib < 8; ++ib) { const f32x4 eb = *(const f32x4*)(EBC + ib * 16 + q * 4); S[ib][0] = S[ib][0] * eb; S[ib][1] = S[ib][1] * eb; }
#pragma unroll
    for (int kk = 0; kk < 2; ++kk) {
        bf16x8 vf[2];
#pragma unroll
        for (int jb = 0; jb < 2; ++jb) { const bf16_t* vp = VT + (kk * 32 + 8 * q + (c >> 2)) * 264 + w * 32 + jb * 16 + 4 * (c & 3); vf[jb] = tr_pair(vp, vp + 4 * 264); }
#pragma unroll
        for (int ib = 0; ib < 8; ++ib) { const bf16x8 kf = *(const bf16x8*)(KDT + (ib * 16 + c) * 72 + kk * 32 + q * 8);
            S[ib][0] = __builtin_amdgcn_mfma_f32_16x16x32_bf16(kf, vf[0], S[ib][0], 0, 0, 0);
            S[ib][1] = __builtin_amdgcn_mfma_f32_16x16x32_bf16(kf, vf[1], S[ib][1], 0, 0, 0); }
    }
}

__device__ __forceinline__ void gla_g1_item(const Params& p, unsigned char* shm, int item) {
    const int tid = tidx(), lane = tid & 63, w = tid >> 6, c = lane & 15, q = lane >> 4;
    const int sc = item >> 2, h = item & 3;
    const bf16_t* PROJ = (const bf16_t*)(p.ws + WS_BIG);
    float* GST = (float*)(p.ws + WS_GST); float* GDEC = (float*)(p.ws + WS_GDEC);
    float wup[16]; const int i = tid & 127;
#pragma unroll
    for (int j = 0; j < 16; ++j) wup[j] = p.in[15][j * 512 + h * 128 + i];
    const float bg = p.in[16][h * 128 + i];
    f32x4 S[8][2];
#pragma unroll
    for (int ib = 0; ib < 8; ++ib) { S[ib][0] = (f32x4){0.f, 0.f, 0.f, 0.f}; S[ib][1] = (f32x4){0.f, 0.f, 0.f, 0.f}; }
    float dec = 0.f;
#pragma unroll 1
    for (int ch = 0; ch < 4; ++ch) {
        dec += gla_preamble<false>(PROJ, shm, sc * 256 + ch * 64, h, wup, bg);
        gla_state_update(S, shm, w, c, q);
        __syncthreads();
    }
    float* dst = GST + (size_t)(sc * 4 + h) * 256 * 128;
#pragma unroll
    for (int ib = 0; ib < 8; ++ib)
#pragma unroll
        for (int jb = 0; jb < 2; ++jb) *(f32x4*)(dst + (size_t)(w * 32 + jb * 16 + c) * 128 + ib * 16 + q * 4) = S[ib][jb];
    if (tid < 128) GDEC[(sc * 4 + h) * 128 + tid] = dec;
}

__device__ __forceinline__ void gla_g2(const Params& p, int wg, int nwg) {
    float* GST = (float*)(p.ws + WS_GST); const float* GDEC = (const float*)(p.ws + WS_GDEC);
    float* og = p.out + O_GP;
    for (int idx = wg * 512 + tidx(); idx < 4 * 256 * 128; idx += nwg * 512) {
        const int h = idx >> 15, j = (idx >> 7) & 255, i = idx & 127;
        float S = 0.f;
        for (int s0 = 0; s0 < 64; s0 += 32) {
            float d[32], a[32];
#pragma unroll
            for (int k = 0; k < 32; ++k) { d[k] = GST[((size_t)((s0 + k) * 4 + h) * 256 + j) * 128 + i]; a[k] = GDEC[((s0 + k) * 4 + h) * 128 + i]; }
#pragma unroll
            for (int k = 0; k < 32; ++k) { GST[((size_t)((s0 + k) * 4 + h) * 256 + j) * 128 + i] = S; S = __expf(a[k]) * S + d[k]; }
        }
        og[(h * 128 + i) * 256 + j] = S;
    }
}

__device__ __forceinline__ void gla_g3_item(const Params& p, unsigned char* shm, int item) {
    const int tid = tidx(), lane = tid & 63, w = tid >> 6, c = lane & 15, q = lane >> 4;
    const int sc = item >> 2, h = item & 3;
    const bf16_t* PROJ = (const bf16_t*)(p.ws + WS_BIG);
    bf16_t* O = (bf16_t*)(p.ws + WS_H);
    const float* GST = (const float*)(p.ws + WS_GST);
    const bf16_t* QD = (const bf16_t*)(shm + G_QD); const bf16_t* KD = (const bf16_t*)(shm + G_KD); const bf16_t* VT = (const bf16_t*)(shm + G_VT);
    bf16_t* AM = (bf16_t*)(shm + G_AM); float* RED = (float*)(shm + G_RED);
    float wup[16]; const int i = tid & 127;
#pragma unroll
    for (int j = 0; j < 16; ++j) wup[j] = p.in[15][j * 512 + h * 128 + i];
    const float bg = p.in[16][h * 128 + i];
    f32x4 S[8][2];
    { const float* src = GST + (size_t)(sc * 4 + h) * 256 * 128;
#pragma unroll
      for (int ib = 0; ib < 8; ++ib)
#pragma unroll
          for (int jb = 0; jb < 2; ++jb) S[ib][jb] = *(const f32x4*)(src + (size_t)(w * 32 + jb * 16 + c) * 128 + ib * 16 + q * 4); }
    const f32x4 ng0 = *(const f32x4*)(p.in[17] + w * 32 + q * 4), ng1 = *(const f32x4*)(p.in[17] + w * 32 + 16 + q * 4);
#pragma unroll 1
    for (int ch = 0; ch < 4; ++ch) {
        const int r0 = sc * 256 + ch * 64;
        gla_preamble<true>(PROJ, shm, r0, h, wup, bg);
        { const int tb = w >> 1;
#pragma unroll
          for (int x = 0; x < 2; ++x) { const int sb = (w & 1) * 2 + x;
              f32x4 a = (f32x4){0.f, 0.f, 0.f, 0.f};
              if (sb <= tb) {
#pragma unroll
                  for (int kk = 0; kk < 4; ++kk) { const bf16x8 af = *(const bf16x8*)(QD + (tb * 16 + c) * 136 + kk * 32 + q * 8), bfv = *(const bf16x8*)(KD + (sb * 16 + c) * 136 + kk * 32 + q * 8);
                      a = __builtin_amdgcn_mfma_f32_16x16x32_bf16(af, bfv, a, 0, 0, 0); } }
#pragma unroll
              for (int e = 0; e < 4; ++e) { const int t = tb * 16 + q * 4 + e, s = sb * 16 + c;
                  AM[t * 72 + s] = (bf16_t)(cvt_pk_bf16(s <= t ? a[e] : 0.f, 0.f) & 0xffffu); } } }
        __syncthreads();
        f32x4 o[2][4];
#pragma unroll
        for (int jb = 0; jb < 2; ++jb)
#pragma unroll
            for (int tb = 0; tb < 4; ++tb) o[jb][tb] = (f32x4){0.f, 0.f, 0.f, 0.f};
#pragma unroll
        for (int pp = 0; pp < 4; ++pp) {
            bf16x8 sf[2];
#pragma unroll
            for (int jb = 0; jb < 2; ++jb) { u32x4 u;
                u[0] = cvt_pk_bf16(S[2 * pp][jb][0], S[2 * pp][jb][1]); u[1] = cvt_pk_bf16(S[2 * pp][jb][2], S[2 * pp][jb][3]);
                u[2] = cvt_pk_bf16(S[2 * pp + 1][jb][0], S[2 * pp + 1][jb][1]); u[3] = cvt_pk_bf16(S[2 * pp + 1][jb][2], S[2 * pp + 1][jb][3]);
                sf[jb] = __builtin_bit_cast(bf16x8, u); }
#pragma unroll
            for (int tb = 0; tb < 4; ++tb) { const bf16_t* qp = QD + (tb * 16 + c) * 136 + 32 * pp + 4 * q;
                const u32x2 a = *(const u32x2*)qp, b = *(const u32x2*)(qp + 16); u32x4 u; u[0] = a[0]; u[1] = a[1]; u[2] = b[0]; u[3] = b[1];
                const bf16x8 qf = __builtin_bit_cast(bf16x8, u);
                o[0][tb] = __builtin_amdgcn_mfma_f32_16x16x32_bf16(sf[0], qf, o[0][tb], 0, 0, 0);
                o[1][tb] = __builtin_amdgcn_mfma_f32_16x16x32_bf16(sf[1], qf, o[1][tb], 0, 0, 0); }
        }
#pragma unroll
        for (int kk = 0; kk < 2; ++kk) {
            bf16x8 vf[2];
#pragma unroll
            for (int jb = 0; jb < 2; ++jb) { const bf16_t* vp = VT + (kk * 32 + 8 * q + (c >> 2)) * 264 + w * 32 + jb * 16 + 4 * (c & 3); vf[jb] = tr_pair(vp, vp + 4 * 264); }
#pragma unroll
            for (int tb = 0; tb < 4; ++tb) { const bf16x8 af = *(const bf16x8*)(AM + (tb * 16 + c) * 72 + kk * 32 + q * 8);
                o[0][tb] = __builtin_amdgcn_mfma_f32_16x16x32_bf16(vf[0], af, o[0][tb], 0, 0, 0);
                o[1][tb] = __builtin_amdgcn_mfma_f32_16x16x32_bf16(vf[1], af, o[1][tb], 0, 0, 0); }
        }
        gla_state_update(S, shm, w, c, q);
#pragma unroll
        for (int tb = 0; tb < 4; ++tb) { float s = 0.f;
#pragma unroll
            for (int jb = 0; jb < 2; ++jb)
#pragma unroll
                for (int e = 0; e < 4; ++e) s += o[jb][tb][e] * o[jb][tb][e];
            s += __shfl_xor(s, 16, 64); s += __shfl_xor(s, 32, 64);
            if (q == 0) RED[w * 64 + tb * 16 + c] = s; }
        __syncthreads();
#pragma unroll
        for (int tb = 0; tb < 4; ++tb) { float s = 0.f;
#pragma unroll
            for (int ww = 0; ww < 8; ++ww) s += RED[ww * 64 + tb * 16 + c];
            const float rs = rsqrtf(s * (1.f / 256.f) + LN_EPS);
            const size_t row = (size_t)(r0 + tb * 16 + c);
#pragma unroll
            for (int jb = 0; jb < 2; ++jb) { const int j = w * 32 + jb * 16 + q * 4;
                const u32x2 ru = *(const u32x2*)(PROJ + row * GLANP + 2048 + h * 256 + j);
                const f32x4 ng = jb ? ng1 : ng0;
                const float v0 = o[jb][tb][0] * rs * ng[0] * siluf(bflo(ru[0])), v1 = o[jb][tb][1] * rs * ng[1] * siluf(bfhi(ru[0]));
                const float v2 = o[jb][tb][2] * rs * ng[2] * siluf(bflo(ru[1])), v3 = o[jb][tb][3] * rs * ng[3] * siluf(bfhi(ru[1]));
                u32x2 u; u[0] = cvt_pk_bf16(v0, v1); u[1] = cvt_pk_bf16(v2, v3);
                *(u32x2*)(O + row * D + h * 256 + j) = u; } }
        __syncthreads();
    }
}

__device__ __forceinline__ void gla_sample_item(const Params& p, unsigned char* shm, int item) {
    const int tid = tidx(), lane = tid & 63, w = tid >> 6;
    const int b = item >> 2, h = item & 3;
    const bf16_t* PROJ = (const bf16_t*)(p.ws + WS_BIG);
    bf16_t* O = (bf16_t*)(p.ws + WS_H);
    float* A_ = (float*)shm; float* Q_ = A_ + 512; float* K_ = Q_ + 512; float* V_ = K_ + 512; float* OP = V_ + 1024; float* RED = OP + 8192;
    { const int i = tid & 127, t = tid >> 7; const size_t row = (size_t)(LP + b * 4 + t);
      float z = p.in[16][h * 128 + i];
#pragma unroll
      for (int j = 0; j < 16; ++j) z += bf2f(PROJ[row * GLANP + 3072 + j]) * p.in[15][j * 512 + h * 128 + i];
      A_[t * 128 + i] = __expf(log_sigmoid(z) * (1.f / 16.f));
      Q_[t * 128 + i] = bf2f(PROJ[row * GLANP + h * 128 + i]) * 0.08838834764831845f;
      K_[t * 128 + i] = bf2f(PROJ[row * GLANP + 512 + h * 128 + i]); }
#pragma unroll
    for (int e = 0; e < 2; ++e) { const int idx = tid + e * 512, t = idx >> 8, j = idx & 255; V_[idx] = bf2f(PROJ[(size_t)(LP + b * 4 + t) * GLANP + 1024 + h * 256 + j]); }
    __syncthreads();
    const float* sin_ = p.in[4] + (size_t)(b * 4 + h) * 128 * 256; float* sout = p.out + O_GS + (size_t)(b * 4 + h) * 128 * 256;
    {
      const int jq = tid & 63, ig = tid >> 6;
      f32x4 vv[4], oo[4];
#pragma unroll
      for (int t = 0; t < 4; ++t) { vv[t] = *(const f32x4*)(V_ + t * 256 + 4 * jq); oo[t] = (f32x4){0.f, 0.f, 0.f, 0.f}; }
      const float* sp = sin_ + (size_t)(ig * 16) * 256 + 4 * jq; float* so = sout + (size_t)(ig * 16) * 256 + 4 * jq;
      f32x4 S[16];
#pragma unroll
      for (int ii = 0; ii < 16; ++ii) S[ii] = *(const f32x4*)(sp + ii * 256);
#pragma unroll
      for (int ii = 0; ii < 16; ++ii) { const int i = ig * 16 + ii;
#pragma unroll
          for (int t = 0; t < 4; ++t) { S[ii] = S[ii] * A_[t * 128 + i] + vv[t] * K_[t * 128 + i]; oo[t] = oo[t] + S[ii] * Q_[t * 128 + i]; }
          *(f32x4*)(so + ii * 256) = S[ii]; }
#pragma unroll
      for (int t = 0; t < 4; ++t) *(f32x4*)(OP + (ig * 4 + t) * 256 + 4 * jq) = oo[t]; }
    __syncthreads();
    const int j = tid & 255, half = tid >> 8;
    const int t0 = half * 2;
    float a0 = 0.f, a1 = 0.f;
#pragma unroll
    for (int g8 = 0; g8 < 8; ++g8) { a0 += OP[(g8 * 4 + t0) * 256 + j]; a1 += OP[(g8 * 4 + t0 + 1) * 256 + j]; }
    const float s0 = wave_sum(a0 * a0), s1 = wave_sum(a1 * a1);
    if (lane == 0) { RED[w * 2] = s0; RED[w * 2 + 1] = s1; }
    __syncthreads();
    const int wb = half * 4;
    const float q0 = RED[wb * 2] + RED[(wb + 1) * 2] + RED[(wb + 2) * 2] + RED[(wb + 3) * 2];
    const float q1 = RED[wb * 2 + 1] + RED[(wb + 1) * 2 + 1] + RED[(wb + 2) * 2 + 1] + RED[(wb + 3) * 2 + 1];
    const float ng = p.in[17][j];
    { const size_t row = (size_t)(LP + b * 4 + t0);
      const float r0v = bf2f(PROJ[row * GLANP + 2048 + h * 256 + j]), r1v = bf2f(PROJ[(row + 1) * GLANP + 2048 + h * 256 + j]);
      O[row * D + h * 256 + j] = (bf16_t)(cvt_pk_bf16(a0 * rsqrtf(q0 * (1.f / 256.f) + LN_EPS) * ng * siluf(r0v), 0.f) & 0xffffu);
      O[(row + 1) * D + h * 256 + j] = (bf16_t)(cvt_pk_bf16(a1 * rsqrtf(q1 * (1.f / 256.f) + LN_EPS) * ng * siluf(r1v), 0.f) & 0xffffu); }
    __syncthreads();
}

#define XB_TMO      128
#define XB_XCNT(j)  (256  + 64 * (j))
#define XB_XSUB(j)  (1280 + 64 * (j))
#define XB_XGEN(j)  (2304 + 64 * (j))
#define XB_TOP      3328
#define XB_TOPGEN   3392
#define XCD_BAR_WORDS 3456
#define XB_SPIN_CAP (1u << 18)

__device__ __forceinline__ unsigned xb_ld(unsigned* p)              { return __hip_atomic_load(p, __ATOMIC_RELAXED, __HIP_MEMORY_SCOPE_AGENT); }
__device__ __forceinline__ unsigned xb_add(unsigned* p, unsigned v) { return __hip_atomic_fetch_add(p, v, __ATOMIC_RELAXED, __HIP_MEMORY_SCOPE_AGENT); }
__device__ __forceinline__ unsigned xb_xcc_id() { return (unsigned)__builtin_amdgcn_s_getreg((3 << 11) | 20) & 0xFu; }
#define XB_SPIN(cond, bar) do { unsigned _sp = 0; while (cond) { __builtin_amdgcn_s_sleep(1); \
    if ((++_sp & 255u) == 0u) { if (xb_ld(&(bar)[XB_TMO])) break; if (_sp > XB_SPIN_CAP) { atomicAdd(&(bar)[XB_TMO], 1u); break; } } } } while (0)

struct XcdBarrier {
    unsigned* bar; unsigned x;
    volatile LAS unsigned* st;
};

__device__ __forceinline__ XcdBarrier xcd_barrier_post(unsigned* bar, volatile LAS unsigned* st) {
    XcdBarrier b; b.bar = bar; b.x = xb_xcc_id(); b.st = st;
    if (threadIdx.x == 0) (void)xb_add(&bar[XB_XCNT(b.x)], 1u);
    return b;
}
__device__ __forceinline__ void xcd_barrier_complete(unsigned* bar, unsigned x, unsigned& nloc, unsigned& nx) {
    const unsigned G = gridDim.x * gridDim.y * gridDim.z;
    unsigned sum, cnt, mine, sp = 0u;
    for (;;) {
        sum = 0u; cnt = 0u; mine = 0u;
#pragma unroll
        for (unsigned j = 0; j < 16; ++j) { const unsigned c = xb_ld(&bar[XB_XCNT(j)]); sum += c; cnt += (c > 0u) ? 1u : 0u; mine = (j == x) ? c : mine; }
        if (sum == G) break;
        __builtin_amdgcn_s_sleep(1);
        if ((++sp & 255u) == 0u) { if (xb_ld(&bar[XB_TMO])) break; if (sp > XB_SPIN_CAP) { atomicAdd(&bar[XB_TMO], 1u); break; } }
    }
    nloc = mine > 0u ? mine : 1u; nx = cnt > 0u ? cnt : 1u;
}

__device__ __forceinline__ void xcd_barrier(const XcdBarrier& b) {
    asm volatile("s_waitcnt vmcnt(0)" ::: "memory");
    __syncthreads();
    if (threadIdx.x == 0) {
        unsigned* bar = b.bar;
        __builtin_amdgcn_s_waitcnt(0);
        unsigned nloc = b.st[0], nx = b.st[1];
        if (nloc == 0u) { xcd_barrier_complete(bar, b.x, nloc, nx); b.st[0] = nloc; b.st[1] = nx; }
        const unsigned old = xb_add(&bar[XB_XSUB(b.x)], 1u);
        const unsigned gen = old / nloc;
        if (old + 1u == (gen + 1u) * nloc) {
            __builtin_amdgcn_fence(__ATOMIC_RELEASE, "agent");
            asm volatile("s_waitcnt vmcnt(0)" ::: "memory");
            const unsigned og = xb_add(&bar[XB_TOP], 1u);
            const unsigned tg = og / nx;
            if (og + 1u == (tg + 1u) * nx) xb_add(&bar[XB_TOPGEN], 1u);
            else XB_SPIN(xb_ld(&bar[XB_TOPGEN]) == tg, bar);
            __builtin_amdgcn_fence(__ATOMIC_ACQUIRE, "agent");
            xb_add(&bar[XB_XGEN(b.x)], 1u);
            asm volatile("s_waitcnt vmcnt(0)" ::: "memory");
        } else {
            XB_SPIN(xb_ld(&bar[XB_XGEN(b.x)]) == gen, bar);
            __builtin_amdgcn_fence(__ATOMIC_ACQUIRE, "agent");
            asm volatile("s_waitcnt vmcnt(0)" ::: "memory");
        }
    }
    __syncthreads();
}

#ifndef USE_XB
#define USE_XB 1
#endif
#ifndef REP_MASK
#define REP_MASK 0u
#endif
#ifndef EXTRA_SYNCS
#define EXTRA_SYNCS 0
#endif
#ifndef PROBE_LN
#define PROBE_LN 0
#endif
#ifndef PROBE_GS
#define PROBE_GS 0
#endif
#ifndef PROBE_W2
#define PROBE_W2 0
#endif
#ifndef ONLY_PH
#define ONLY_PH -1
#endif
#define PHSEL(n) (ONLY_PH < 0 || ONLY_PH == (n))
__global__ void __launch_bounds__(512, 2) mega(Params p) {
    extern __shared__ __attribute__((aligned(16))) unsigned char shm[];
    cg::grid_group grid = cg::this_grid();
    const int wg = blockIdx.x, nwg = gridDim.x;
    unsigned char* ws = p.ws;
    const float* MOD = (const float*)(ws + WS_MOD);
    bf16_t* Hb = (bf16_t*)(ws + WS_H);
    bf16_t* BIG = (bf16_t*)(ws + WS_BIG);
    LAS unsigned char* lds = (LAS unsigned char*)shm;
    volatile LAS unsigned* xst = (volatile LAS unsigned*)(lds + 131072);
    if (threadIdx.x == 0) { xst[0] = 0u; xst[1] = 0u; }
    __syncthreads();
    const XcdBarrier xb = xcd_barrier_post((unsigned*)(ws + WS_CTL), xst);
#define GSYNC() do { if (USE_XB) xcd_barrier(xb); else grid.sync(); } while (0)
#define PH(n) if (PHSEL(n))
    if (p.ph_lo == 0x7fffffff) grid.sync();
    PH(0) phase_prep(p, shm, wg, nwg, 0);
    GSYNC();
    PH(1) { pg8::Gemm g{(const bf16_t*)(ws + WS_CMAT), BIG, CPAD, MODN, D, D}; pg8::StaticOrder S; S.init(CPAD, MODN, nwg, wg);
            pg8::EpiF32 E{(float*)(ws + WS_MOD), MODN, p.in[8]}; pg8::gemm_phase(lds, g, S, E); }
    PH(0) if (wg >= 48) phase_prep(p, shm, wg - 48, nwg - 48, 1);
    GSYNC();
    PH(2) phase_mod0(p, wg, nwg);
    GSYNC();
#pragma unroll 1
    for (int l = 0; l < 2; ++l) {
        PH(3) { const int N = l ? GLANP : NQKV;
                pg8::Gemm g{Hb, (const bf16_t*)(ws + (l ? WS_WT_GIN : WS_WT_AIN)), R, N, D, D}; pg8::StaticOrder S; S.init(R, N, nwg, wg);
                pg8::EpiBf16 E{BIG, N, 0}; pg8::gemm_phase(lds, g, S, E); }
        PH(0) if (l == 0 && wg >= 140) phase_prep(p, shm, wg - 140, nwg - 140, 2);
        GSYNC();
        if (l == 0) {
            PH(4) for (int u = wg; u < 512 + 256; u += nwg) { if (u < 512) attn_prompt_unit(p, shm, u); else attn_sample_pair(p, shm, u - 512); }
            GSYNC();
        } else {
            PH(11) for (int u = wg; u < 256; u += nwg) gla_g1_item(p, shm, u);
            GSYNC();
            PH(12) { gla_g2(p, wg, nwg); for (int u = wg; u < 512; u += nwg) gla_sample_item(p, shm, u); }
            GSYNC();
            PH(13) for (int u = wg; u < 256; u += nwg) gla_g3_item(p, shm, u);
            GSYNC();
        }
        PH(5) { pg8::Gemm g{Hb, (const bf16_t*)(ws + (l ? WS_WT_GOUT : WS_WT_AOUT)), R, D, D, 256}; pg8::SplitOrder S; S.init(D, 4, nwg, wg);
                pg8::EpiResid E{(bf16_t*)(ws + WS_YB), l ? nullptr : p.in[0], MOD + (2 * l) * 3072 + 2048, (float*)(ws + WS_PART), p.in[9] + 1 * D, p.in[10] + 1 * D, (const float*)(ws + WS_STATS)}; pg8::gemm_phase(lds, g, S, E); }
        GSYNC();
        PH(6) phase_ln(p, 2 * l, 2 * l + 1, 4, 2 * l, wg, nwg);
        GSYNC();
        PH(7) { pg8::Gemm g{Hb, (const bf16_t*)(ws + WS_WT_W1) + (size_t)l * DFF * D, R, DFF, D, D}; pg8::StaticOrder S; S.init(R, DFF, nwg, wg);
                pg8::EpiBf16 E{BIG, DFF, 1}; pg8::gemm_phase(lds, g, S, E); }
        GSYNC();
        PH(8) { pg8::Gemm g{BIG, (const bf16_t*)(ws + WS_WT_W2) + (size_t)l * D * DFF, R, D, DFF, 256}; pg8::SplitOrder S; S.init(D, 16, nwg, wg);
                pg8::EpiResid E{(bf16_t*)(ws + WS_YB), nullptr, MOD + (l * 2 + 1) * 3072 + 2048, (float*)(ws + WS_PART), p.in[9] + (l * 2) * D, p.in[10] + (l * 2) * D, (const float*)(ws + WS_STATS)}; pg8::gemm_phase(lds, g, S, E); }
        GSYNC();
        PH(9) phase_ln(p, 2 * l + 1, l ? -1 : 2, 16, 2 * l + 1, wg, nwg);
        if (l == 0) GSYNC();
    }
}

#ifndef MK_ONE_LAUNCH
#define MK_ONE_LAUNCH 1
#endif

extern "C" void kernel_launch(void* const* d_in, const int* in_sizes, int n_in, void* d_out, int out_size, void* d_ws, size_t ws_size, hipStream_t stream) {
    static int grid = 0;
    if (grid == 0) {
        if (n_in != 21 || ws_size < WS_END) { fprintf(stderr, "kernel_launch: unexpected n_in %d or ws_size %zu (< %zu)\n", n_in, ws_size, (size_t)WS_END); grid = -1; return; }
        int dev = 0, cus = 0, per_cu = 0;
        hipGetDevice(&dev);
        hipDeviceGetAttribute(&cus, hipDeviceAttributeMultiprocessorCount, dev);
        if (hipFuncSetAttribute((const void*)mega, hipFuncAttributeMaxDynamicSharedMemorySize, LDS_BYTES) != hipSuccess) { fprintf(stderr, "kernel_launch: hipFuncSetAttribute failed\n"); grid = -1; return; }
        if (hipOccupancyMaxActiveBlocksPerMultiprocessor(&per_cu, (const void*)mega, 512, LDS_BYTES) != hipSuccess || per_cu < 1) { fprintf(stderr, "kernel_launch: occupancy query failed (%d)\n", per_cu); per_cu = 1; }
        (void)hipGetLastError();
        grid = cus * per_cu;
    }
    if (grid < 0) return;
    if (hipMemsetAsync((char*)d_ws + WS_CTL, 0, CTL_BYTES, stream) != hipSuccess) { fprintf(stderr, "kernel_launch: memset failed\n"); return; }
    Params p{};
    for (int i = 0; i < 21; ++i) p.in[i] = (const float*)d_in[i];
    p.out = (float*)d_out; p.ws = (unsigned char*)d_ws;
#if MK_ONE_LAUNCH
    p.ph_lo = 0; p.ph_hi = NPH;
    void* args[] = {&p};
    hipError_t e = hipLaunchCooperativeKernel((const void*)mega, dim3(grid), dim3(512), args, LDS_BYTES, stream);
    if (e != hipSuccess) fprintf(stderr, "cooperative launch failed: %s (grid %d)\n", hipGetErrorString(e), grid);
#else
    for (int ph = 0; ph < NPH; ++ph) {
        p.ph_lo = ph; p.ph_hi = ph + 1;
        hipLaunchKernelGGL(mega, dim3(grid), dim3(512), LDS_BYTES, stream, p);
    }
#endif
}
```
